# Optimizing an MI355X kernel written in HIP

```python
import math
import jax, jax.numpy as jnp
from jax import lax
import numpy as np

D_MODEL = 2048
BATCH = 4
SEQ = 2048
DEPTH = 2
DEC_BATCH = 2
DEC_SEQ = 4096
PAST_LEN = 128

HEAD_DIM = 128
A_Q_HEADS = 4
A_KV_HEADS = 2
A_GROUP = A_Q_HEADS // A_KV_HEADS
A_HALF_WINDOW = 128
B_Q_HEADS = 6
B_KV_HEADS = 2
B_GROUP = B_Q_HEADS // B_KV_HEADS
B_QUERY_BLOCK = 128
ROPE_THETA = 10000.0
GRID_W = 64
C_PAIRS = ((128, 1), (512, 4), (2048, 16))
N_PAIRS = 3
C_SLOTS = 2
C_KV_PER_PAIR = 1
C_GROUP = C_SLOTS // C_KV_PER_PAIR
C_Q_HEADS = N_PAIRS * C_SLOTS
C_KV_HEADS = N_PAIRS * C_KV_PER_PAIR
NUM_BUCKETS = 32
REL_MAX_DISTANCE = 2048
D_FF = 5632
FFN_RESIDUAL = 0.5
N_BRANCHES = 3
NORM_EPS = 1e-6
MASK_VALUE = -1e30
IN_SIZES = (A_Q_HEADS * HEAD_DIM, A_KV_HEADS * HEAD_DIM, A_KV_HEADS * HEAD_DIM,
            B_Q_HEADS * HEAD_DIM, B_KV_HEADS * HEAD_DIM, B_KV_HEADS * HEAD_DIM,
            C_Q_HEADS * HEAD_DIM, C_KV_HEADS * HEAD_DIM, C_KV_HEADS * HEAD_DIM)
IN_COLS = sum(IN_SIZES)
IN_SPLIT_POINTS = tuple(int(v) for v in np.cumsum(IN_SIZES)[:-1])

kernel_name = 'hybrid_gated_parallel_encoder'


def rms_norm(x, gain):
    xf = x.astype(jnp.float32)
    y = xf * lax.rsqrt(jnp.mean(xf * xf, axis=-1, keepdims=True) + NORM_EPS)
    return (y * gain.astype(jnp.float32)).astype(x.dtype)


def swiglu(h, w13, w2):
    gate, up = jnp.split(h @ w13, 2, axis=-1)
    return (jax.nn.silu(gate) * up) @ w2


def t5_bucket(rel):
    half = NUM_BUCKETS // 2
    max_exact = half // 2
    ret = jnp.where(rel > 0, half, 0)
    n = jnp.abs(rel)
    nf = jnp.maximum(n, 1).astype(jnp.float32)
    large = max_exact + (jnp.log(nf / max_exact) / math.log(REL_MAX_DISTANCE / max_exact)
                         * (half - max_exact)).astype(jnp.int32)
    large = jnp.minimum(large, half - 1)
    return ret + jnp.where(n < max_exact, n, large)


def banded_gqa(q, k, v, half_window, dilation, bias_table, sink):
    n, L, kvh, g, hd = q.shape
    blk = half_window
    nb = -(-L // blk)
    lp = nb * blk
    q = jnp.pad(q, ((0, 0), (0, lp - L), (0, 0), (0, 0), (0, 0)))
    pad_kv = ((0, 0), (blk, lp - L + blk), (0, 0), (0, 0))
    kp = jnp.pad(k, pad_kv).reshape(n, nb + 2, blk, kvh, hd)
    vp = jnp.pad(v, pad_kv).reshape(n, nb + 2, blk, kvh, hd)
    kw = jnp.concatenate([kp[:, :-2], kp[:, 1:-1], kp[:, 2:]], axis=2).astype(jnp.float32)
    vw = jnp.concatenate([vp[:, :-2], vp[:, 1:-1], vp[:, 2:]], axis=2).astype(jnp.float32)
    qc = q.reshape(n, nb, blk, kvh, g, hd).astype(jnp.float32)
    logits = jnp.einsum('ncqkgd,ncskd->nckgqs', qc, kw) / math.sqrt(hd)
    rel = jnp.arange(3 * blk)[None, :] - blk - jnp.arange(blk)[:, None]
    bias = jnp.transpose(bias_table[t5_bucket(rel * dilation)], (2, 3, 0, 1)).astype(jnp.float32)
    key_pos = jnp.arange(nb)[:, None] * blk - blk + jnp.arange(3 * blk)[None, :]
    valid = (jnp.abs(rel) <= half_window)[None] & ((key_pos >= 0) & (key_pos < L))[:, None, :]
    logits = jnp.where(valid[None, :, None, None], logits + bias, MASK_VALUE)
    m = jnp.max(logits, axis=-1)
    if sink is not None:
        sink_b = sink.astype(jnp.float32)[None, None, :, :, None]
        m = jnp.maximum(m, sink_b)
    p = jnp.exp(logits - m[..., None])
    denom = jnp.sum(p, axis=-1)
    if sink is not None:
        denom = denom + jnp.exp(sink_b - m)
    out = jnp.einsum('nckgqs,ncskd->ncqkgd', p, vw)
    denom_t = jnp.transpose(denom, (0, 1, 4, 2, 3))
    out = (out / denom_t[..., None]).reshape(n, lp, kvh, g, hd)[:, :L]
    lse = jnp.transpose(m + jnp.log(denom), (0, 1, 4, 2, 3)).reshape(n, lp, kvh, g)[:, :L]
    return out, lse


def head_rms_norm(x, gain):
    xf = x.astype(jnp.float32)
    y = xf * lax.rsqrt(jnp.mean(xf * xf, axis=-1, keepdims=True) + NORM_EPS)
    return y * gain.astype(jnp.float32)


def axial_rope_angles(s):
    rows = s // GRID_W
    row_ids = jnp.repeat(jnp.arange(rows), GRID_W).astype(jnp.float32)
    col_ids = jnp.tile(jnp.arange(GRID_W), rows).astype(jnp.float32)
    axis_dim = HEAD_DIM // 2
    inv_freq = ROPE_THETA ** (-jnp.arange(0, axis_dim, 2, dtype=jnp.float32) / axis_dim)
    ang = jnp.stack([row_ids[:, None] * inv_freq, col_ids[:, None] * inv_freq], axis=1)
    return jnp.cos(ang), jnp.sin(ang)


def apply_axial_rope(x, cos, sin):
    s = x.shape[1]
    quarter = HEAD_DIM // 4
    xr = x.reshape(x.shape[:-1] + (2, 2, quarter))
    bshape = (1, s) + (1,) * (x.ndim - 3) + (2, quarter)
    c = cos.reshape(bshape)
    sn = sin.reshape(bshape)
    x1 = xr[..., 0, :]
    x2 = xr[..., 1, :]
    rot = jnp.stack([x1 * c - x2 * sn, x2 * c + x1 * sn], axis=-2)
    return rot.reshape(x.shape)


def block_sweep_gqa(q, k, v):
    b, s, kvh, g, hd = q.shape
    nb = s // B_QUERY_BLOCK
    qb = jnp.moveaxis(q.reshape(b, nb, B_QUERY_BLOCK, kvh, g, hd), 1, 0)
    kf = k.astype(jnp.float32)
    vf = v.astype(jnp.float32)

    def one_block(qblk):
        logits = jnp.einsum('bqkgd,bskd->bkgqs', qblk.astype(jnp.float32), kf) / math.sqrt(hd)
        p = jax.nn.softmax(logits, axis=-1)
        return jnp.einsum('bkgqs,bskd->bqkgd', p, vf)

    out = lax.map(one_block, qb)
    return jnp.moveaxis(out, 0, 1).reshape(b, s, kvh, g, hd)


def _stride_split(z, r):
    b, s = z.shape[:2]
    z = z.reshape((b, s // r, r) + z.shape[2:])
    return jnp.swapaxes(z, 1, 2).reshape((b * r, s // r) + z.shape[3:])


def _stride_merge(z, b, r):
    m = z.shape[1]
    z = z.reshape((b, r, m) + z.shape[2:])
    return jnp.swapaxes(z, 1, 2).reshape((b, r * m) + z.shape[3:])


def dilated_mixture(q, k, v, bias_table):
    b = q.shape[0]
    outs, lses = [], []
    for i, (window, dilation) in enumerate(C_PAIRS):
        o, l = banded_gqa(_stride_split(q[:, :, i], dilation), _stride_split(k[:, :, i], dilation),
                          _stride_split(v[:, :, i], dilation), window // (2 * dilation), dilation,
                          bias_table[:, i], None)
        outs.append(_stride_merge(o, b, dilation))
        lses.append(_stride_merge(l, b, dilation))
    weights = jax.nn.softmax(jnp.stack(lses, axis=0), axis=0)
    return jnp.sum(weights[..., None] * jnp.stack(outs, axis=0), axis=0)


def encoder_layer(x, ffn1_norm, ffn1_w13, ffn1_w2, mix_norm, w_in, q_gain_b, k_gain_b, sink_a,
                  w_gate, b_gate, w_br_a, w_br_b, w_br_c, w_o, ffn2_norm, ffn2_w13, ffn2_w2, rel_bias):
    b, s, _ = x.shape
    dt = x.dtype
    x = x + FFN_RESIDUAL * swiglu(rms_norm(x, ffn1_norm), ffn1_w13, ffn1_w2)
    h = rms_norm(x, mix_norm)
    z = h @ w_in
    aq, ak, av, bq, bk, bv, cq, ck, cv = jnp.split(z, IN_SPLIT_POINTS, axis=-1)
    ya, _ = banded_gqa(aq.reshape(b, s, A_KV_HEADS, A_GROUP, HEAD_DIM),
                       ak.reshape(b, s, A_KV_HEADS, HEAD_DIM),
                       av.reshape(b, s, A_KV_HEADS, HEAD_DIM),
                       A_HALF_WINDOW, 1,
                       rel_bias[:, :A_Q_HEADS].reshape(NUM_BUCKETS, A_KV_HEADS, A_GROUP),
                       sink_a.reshape(A_KV_HEADS, A_GROUP))
    cos, sin = axial_rope_angles(s)
    qb = apply_axial_rope(head_rms_norm(bq.reshape(b, s, B_KV_HEADS, B_GROUP, HEAD_DIM), q_gain_b), cos, sin)
    kb = apply_axial_rope(head_rms_norm(bk.reshape(b, s, B_KV_HEADS, HEAD_DIM), k_gain_b), cos, sin)
    yb = block_sweep_gqa(qb, kb, bv.reshape(b, s, B_KV_HEADS, HEAD_DIM))
    yc = dilated_mixture(cq.reshape(b, s, N_PAIRS, C_KV_PER_PAIR, C_GROUP, HEAD_DIM),
                         ck.reshape(b, s, N_PAIRS, C_KV_PER_PAIR, HEAD_DIM),
                         cv.reshape(b, s, N_PAIRS, C_KV_PER_PAIR, HEAD_DIM),
                         rel_bias[:, A_Q_HEADS:].reshape(NUM_BUCKETS, N_PAIRS, C_KV_PER_PAIR, C_GROUP))
    gates = jax.nn.sigmoid((h @ w_gate + b_gate).astype(jnp.float32)).reshape(b, s, N_BRANCHES, D_MODEL)
    br_a = (ya.reshape(b, s, -1).astype(dt) @ w_br_a).astype(jnp.float32)
    br_b = (yb.reshape(b, s, -1).astype(dt) @ w_br_b).astype(jnp.float32)
    br_c = (yc.reshape(b, s, -1).astype(dt) @ w_br_c).astype(jnp.float32)
    merged = gates[:, :, 0] * br_a + gates[:, :, 1] * br_b + gates[:, :, 2] * br_c
    x = x + merged.astype(dt) @ w_o
    x = x + FFN_RESIDUAL * swiglu(rms_norm(x, ffn2_norm), ffn2_w13, ffn2_w2)
    return x


def encoder_trunk(x, ffn1_norm, ffn1_w13, ffn1_w2, mix_norm, w_in, q_gain_b, k_gain_b, sink_a,
                  w_gate, b_gate, w_br_a, w_br_b, w_br_c, w_o, ffn2_norm, ffn2_w13, ffn2_w2,
                  rel_bias, final_norm):
    for li in range(DEPTH):
        x = encoder_layer(x, ffn1_norm[li], ffn1_w13[li], ffn1_w2[li], mix_norm[li], w_in[li],
                          q_gain_b[li], k_gain_b[li], sink_a[li], w_gate[li], b_gate[li],
                          w_br_a[li], w_br_b[li], w_br_c[li], w_o[li],
                          ffn2_norm[li], ffn2_w13[li], ffn2_w2[li], rel_bias)
    return rms_norm(x, final_norm)


def _normal(key, shape, scale):
    return jax.random.normal(key, shape, jnp.float32) * scale


def setup_inputs(seed: int = 0) -> dict:
    key = jax.random.key(seed)
    ks = jax.random.split(key, 21)
    D, L = D_MODEL, DEPTH
    return {
        'x_prompt': _normal(ks[0], (BATCH, SEQ, D), 1.0),
        'x_sample': _normal(ks[1], (DEC_BATCH, DEC_SEQ, D), 1.0),
        'ffn1_norm': 1.0 + _normal(ks[2], (L, D), 0.01),
        'ffn1_w13': _normal(ks[3], (L, D, 2 * D_FF), D ** -0.5),
        'ffn1_w2': _normal(ks[4], (L, D_FF, D), D_FF ** -0.5),
        'mix_norm': 1.0 + _normal(ks[5], (L, D), 0.01),
        'w_in': _normal(ks[6], (L, D, IN_COLS), D ** -0.5),
        'q_gain_b': 1.0 + _normal(ks[7], (L, HEAD_DIM), 0.01),
        'k_gain_b': 1.0 + _normal(ks[8], (L, HEAD_DIM), 0.01),
        'sink_a': _normal(ks[9], (L, A_Q_HEADS), 0.5),
        'w_gate': _normal(ks[10], (L, D, N_BRANCHES * D), D ** -0.5),
        'b_gate': _normal(ks[11], (L, N_BRANCHES * D), 0.02),
        'w_br_a': _normal(ks[12], (L, A_Q_HEADS * HEAD_DIM, D), (A_Q_HEADS * HEAD_DIM) ** -0.5),
        'w_br_b': _normal(ks[13], (L, B_Q_HEADS * HEAD_DIM, D), (B_Q_HEADS * HEAD_DIM) ** -0.5),
        'w_br_c': _normal(ks[14], (L, C_SLOTS * HEAD_DIM, D), (C_SLOTS * HEAD_DIM) ** -0.5),
        'w_o': _normal(ks[15], (L, D, D), D ** -0.5),
        'ffn2_norm': 1.0 + _normal(ks[16], (L, D), 0.01),
        'ffn2_w13': _normal(ks[17], (L, D, 2 * D_FF), D ** -0.5),
        'ffn2_w2': _normal(ks[18], (L, D_FF, D), D_FF ** -0.5),
        'rel_bias': _normal(ks[19], (NUM_BUCKETS, A_Q_HEADS + C_Q_HEADS), 0.1),
        'final_norm': 1.0 + _normal(ks[20], (D,), 0.01),
    }


def reference(x_prompt, x_sample, ffn1_norm, ffn1_w13, ffn1_w2, mix_norm, w_in, q_gain_b, k_gain_b,
              sink_a, w_gate, b_gate, w_br_a, w_br_b, w_br_c, w_o, ffn2_norm, ffn2_w13, ffn2_w2,
              rel_bias, final_norm):
    y_prompt = encoder_trunk(x_prompt, ffn1_norm, ffn1_w13, ffn1_w2, mix_norm, w_in, q_gain_b, k_gain_b,
                             sink_a, w_gate, b_gate, w_br_a, w_br_b, w_br_c, w_o, ffn2_norm, ffn2_w13,
                             ffn2_w2, rel_bias, final_norm)
    y_sample = encoder_trunk(x_sample, ffn1_norm, ffn1_w13, ffn1_w2, mix_norm, w_in, q_gain_b, k_gain_b,
                             sink_a, w_gate, b_gate, w_br_a, w_br_b, w_br_c, w_o, ffn2_norm, ffn2_w13,
                             ffn2_w2, rel_bias, final_norm)
    return (y_prompt, y_sample)
```

```cpp
#include <hip/hip_runtime.h>
#include <hip/hip_cooperative_groups.h>
#include <cstdio>
#include <cstdint>
namespace cg = cooperative_groups;

#define LAS __attribute__((address_space(3)))
typedef unsigned short bf16_t;
typedef short bf16x8 __attribute__((ext_vector_type(8)));
typedef short s16x4 __attribute__((ext_vector_type(4)));
typedef float f32x4 __attribute__((ext_vector_type(4)));
typedef float f32x2 __attribute__((ext_vector_type(2)));
typedef float f32x16 __attribute__((ext_vector_type(16)));
typedef unsigned u32x4 __attribute__((ext_vector_type(4)));
typedef unsigned u32x2 __attribute__((ext_vector_type(2)));
typedef int v8i __attribute__((ext_vector_type(8)));
typedef int v4i __attribute__((ext_vector_type(4)));
typedef float v8f __attribute__((ext_vector_type(8)));

constexpr int DM = 2048, MTOK = 16384, DFF = 5632, NIN = 3840, NG = 6144, NY = 1536, DEPTH = 2;
constexpr float NORM_EPS = 1e-6f;
constexpr float LOG2E = 1.4426950408889634f;

typedef __bf16 bf16x2_t __attribute__((ext_vector_type(2)));
__device__ __forceinline__ unsigned cvt_pk_bf16(float lo, float hi) { f32x2 v = {lo, hi}; bf16x2_t b = __builtin_convertvector(v, bf16x2_t); return __builtin_bit_cast(unsigned, b); }
__device__ __forceinline__ float bf_lo(unsigned w) { return __uint_as_float(w << 16); }
__device__ __forceinline__ float bf_hi(unsigned w) { return __uint_as_float(w & 0xffff0000u); }
__device__ __forceinline__ float bf2f(bf16_t v) { return __uint_as_float(((unsigned)v) << 16); }
__device__ __forceinline__ float fast_sigmoid(float v) { return __builtin_amdgcn_rcpf(1.0f + __builtin_amdgcn_exp2f(-v * LOG2E)); }
__device__ __forceinline__ u32x2 cvt8_fp8(float a0, float a1, float a2, float a3, float a4, float a5, float a6, float a7);
#define LDS_WAIT() asm volatile("s_waitcnt lgkmcnt(0)" ::: "memory")

namespace pg8 {
constexpr int BM = 256, BK = 64, HALF = 128, HTB = HALF * BK * 2, STAGE_BYTES = 8 * HTB, NXCD = 8, WGM = 4;
__host__ __device__ __forceinline__ int lds_byte(int r, int c) { const int st = (r >> 4) * 2 + (c >> 5), rr = r & 15, cc = c & 31, ob = rr * 64 + cc * 2; return st * 1024 + (ob ^ (((ob >> 9) & 1) << 5)); }
__host__ __device__ __forceinline__ void stage_rc(int b, int& R, int& C) { const int st = b / 1024, sb = b % 1024, swz = sb ^ (((sb >> 9) & 1) << 5); R = (st >> 1) * 16 + swz / 64; C = (st & 1) * 32 + (swz % 64) / 2; }
__host__ __device__ __forceinline__ int perm32(int rho) { const int n = rho >> 4, i = rho & 15; return 8 * (i >> 2) + 4 * n + (i & 3); }

struct Unit { int pm, pn; };
struct Gemm { const bf16_t* A; const bf16_t* Bt; int M, N, K, lda, ldb; };

struct StaticOrder {
    int nM, nN, nwg, G, c;
    __device__ void init(int M, int N, int G_, int c_) { nM = M / BM; nN = N / BM; nwg = nM * nN; G = G_; c = c_; }
    __device__ bool next(int i, Unit& u) const {
        const long L = (long)i * G + c; if (L >= nwg) return false;
        int wgid = (int)L; { const int q = nwg / NXCD, r = nwg % NXCD, xcd = wgid % NXCD, off = wgid / NXCD; wgid = (xcd < r ? xcd * (q + 1) : r * (q + 1) + (xcd - r) * q) + off; }
        const int nig = WGM * nN, gid = wgid / nig, fm = gid * WGM, gsz = (nM - fm) < WGM ? (nM - fm) : WGM;
        u.pm = fm + ((wgid % nig) % gsz); u.pn = (wgid % nig) / gsz; return true;
    }
};

template <int ACT  > struct EpiBf16 {
    static constexpr bool PERM = true;
    bf16_t* O; int ldc; const float* bias; const float* ssq; float oscale;
    __device__ __forceinline__ void operator()(const f32x4 (&acc)[2][2][4][2], const Unit& u, int wr, int wc, int fr, int fq) const {
        const int row0 = u.pm * BM + wr * 64 + fr; const int col0 = u.pn * BM + wc * 32 + 8 * fq;
        float rs[2][4];
#pragma unroll
        for (int ai = 0; ai < 2; ++ai)
#pragma unroll
            for (int m = 0; m < 4; ++m) rs[ai][m] = oscale * __builtin_amdgcn_rsqf(ssq[row0 + ai * HALF + m * 16] * (1.0f / DM) + NORM_EPS);
        f32x4 bv[2][2];
#pragma unroll
        for (int bj = 0; bj < 2; ++bj)
#pragma unroll
            for (int n = 0; n < 2; ++n) bv[bj][n] = bias ? *(const f32x4*)(bias + col0 + bj * HALF + 4 * n) : (f32x4){0.f, 0.f, 0.f, 0.f};
#pragma unroll
        for (int ai = 0; ai < 2; ++ai)
#pragma unroll
            for (int m = 0; m < 4; ++m) { bf16_t* rowp = O + (size_t)(row0 + ai * HALF + m * 16) * ldc + col0;
#pragma unroll
                for (int bj = 0; bj < 2; ++bj) { f32x4 v0 = acc[ai][bj][m][0] * rs[ai][m] + bv[bj][0], v1 = acc[ai][bj][m][1] * rs[ai][m] + bv[bj][1];
                    if (ACT == 2) {
#pragma unroll
                        for (int j = 0; j < 4; ++j) { v0[j] = fast_sigmoid(v0[j]); v1[j] = fast_sigmoid(v1[j]); } }
                    u32x4 w; w.x = cvt_pk_bf16(v0[0], v0[1]); w.y = cvt_pk_bf16(v0[2], v0[3]); w.z = cvt_pk_bf16(v1[0], v1[1]); w.w = cvt_pk_bf16(v1[2], v1[3]);
                    *(u32x4*)(rowp + bj * HALF) = w; } }
    }
};
struct EpiSwiGLU {
    static constexpr bool PERM = true;
    bf16_t* O; int ldc; const float* ssq;
    __device__ __forceinline__ void operator()(const f32x4 (&acc)[2][2][4][2], const Unit& u, int wr, int wc, int fr, int fq) const {
        const int row0 = u.pm * BM + wr * 64 + fr; const int col0 = u.pn * HALF + wc * 32 + 8 * fq;
#pragma unroll
        for (int ai = 0; ai < 2; ++ai)
#pragma unroll
            for (int m = 0; m < 4; ++m) { bf16_t* rowp = O + (size_t)(row0 + ai * HALF + m * 16) * ldc + col0;
                const float rs = __builtin_amdgcn_rsqf(ssq[row0 + ai * HALF + m * 16] * (1.0f / DM) + NORM_EPS);
                f32x4 g0 = acc[ai][0][m][0] * rs, g1 = acc[ai][0][m][1] * rs; const f32x4 u0 = acc[ai][1][m][0] * rs, u1 = acc[ai][1][m][1] * rs;
#pragma unroll
                for (int j = 0; j < 4; ++j) { g0[j] = g0[j] * fast_sigmoid(g0[j]) * u0[j]; g1[j] = g1[j] * fast_sigmoid(g1[j]) * u1[j]; }
                u32x4 w; w.x = cvt_pk_bf16(g0[0], g0[1]); w.y = cvt_pk_bf16(g0[2], g0[3]); w.z = cvt_pk_bf16(g1[0], g1[1]); w.w = cvt_pk_bf16(g1[2], g1[3]);
                *(u32x4*)rowp = w; }
    }
};
template <bool FP8X, bool NEXT = true> struct EpiResid {
    static constexpr bool PERM = true;
    float* X; bf16_t* XB; float* ssq; int ldc; float scale; unsigned char* X8;
    __device__ __forceinline__ void operator()(const f32x4 (&acc)[2][2][4][2], const Unit& u, int wr, int wc, int fr, int fq) const {
        const int row0 = u.pm * BM + wr * 64 + fr; const int col0 = u.pn * BM + wc * 32 + 8 * fq;
#pragma unroll
        for (int ai = 0; ai < 2; ++ai) {
            f32x4 pre[4][2][2];
#pragma unroll
            for (int m = 0; m < 4; ++m) { const float* rowp = X + (size_t)(row0 + ai * HALF + m * 16) * ldc + col0;
#pragma unroll
                for (int bj = 0; bj < 2; ++bj) { pre[m][bj][0] = *(const f32x4*)(rowp + bj * HALF); pre[m][bj][1] = *(const f32x4*)(rowp + bj * HALF + 4); } }
            asm volatile("" ::: "memory");
#pragma unroll
            for (int m = 0; m < 4; ++m) { const int row = row0 + ai * HALF + m * 16; float* rowp = X + (size_t)row * ldc + col0; bf16_t* rowb = XB + (size_t)row * ldc + col0; float part = 0.f;
#pragma unroll
                for (int bj = 0; bj < 2; ++bj) { float* p = rowp + bj * HALF;
                    const f32x4 a = pre[m][bj][0] + acc[ai][bj][m][0] * scale, b = pre[m][bj][1] + acc[ai][bj][m][1] * scale; *(f32x4*)p = a; *(f32x4*)(p + 4) = b;
                    part += (a[0] * a[0] + a[1] * a[1]) + (a[2] * a[2] + a[3] * a[3]) + (b[0] * b[0] + b[1] * b[1]) + (b[2] * b[2] + b[3] * b[3]);
                    if (NEXT) { u32x4 w; w.x = cvt_pk_bf16(a[0], a[1]); w.y = cvt_pk_bf16(a[2], a[3]); w.z = cvt_pk_bf16(b[0], b[1]); w.w = cvt_pk_bf16(b[2], b[3]);
                    *(u32x4*)(rowb + bj * HALF) = w; }
                    if (FP8X) *(u32x2*)(X8 + (size_t)row * ldc + col0 + bj * HALF) = cvt8_fp8(a[0], a[1], a[2], a[3], b[0], b[1], b[2], b[3]); }
                if (NEXT) { part += __shfl_xor(part, 16); part += __shfl_xor(part, 32);
                if (fq == 0) __hip_atomic_fetch_add(ssq + row, part, __ATOMIC_RELAXED, __HIP_MEMORY_SCOPE_AGENT); } }
            asm volatile("" ::: "memory");
        }
    }
};
template <bool FIRST> struct EpiGateMul {
    static constexpr bool PERM = true;
    const bf16_t* Gt; int ldg; bf16_t* O; int ldc;
    __device__ __forceinline__ void operator()(const f32x4 (&acc)[2][2][4][2], const Unit& u, int wr, int wc, int fr, int fq) const {
        const int row0 = u.pm * BM + wr * 64 + fr; const int col0 = u.pn * BM + wc * 32 + 8 * fq;
#pragma unroll
        for (int ai = 0; ai < 2; ++ai) {
            u32x4 gv[4][2], mv[4][2];
#pragma unroll
            for (int m = 0; m < 4; ++m) { const size_t row = (size_t)(row0 + ai * HALF + m * 16);
#pragma unroll
                for (int bj = 0; bj < 2; ++bj) { gv[m][bj] = *(const u32x4*)(Gt + row * ldg + col0 + bj * HALF); if (!FIRST) mv[m][bj] = *(const u32x4*)(O + row * ldc + col0 + bj * HALF); } }
            asm volatile("" ::: "memory");
#pragma unroll
            for (int m = 0; m < 4; ++m) { const size_t row = (size_t)(row0 + ai * HALF + m * 16);
#pragma unroll
                for (int bj = 0; bj < 2; ++bj) { bf16_t* op = O + row * ldc + col0 + bj * HALF; const u32x4 g = gv[m][bj];
                    f32x4 v0 = acc[ai][bj][m][0], v1 = acc[ai][bj][m][1];
                    v0[0] *= bf_lo(g.x); v0[1] *= bf_hi(g.x); v0[2] *= bf_lo(g.y); v0[3] *= bf_hi(g.y);
                    v1[0] *= bf_lo(g.z); v1[1] *= bf_hi(g.z); v1[2] *= bf_lo(g.w); v1[3] *= bf_hi(g.w);
                    if (!FIRST) { const u32x4 mm = mv[m][bj];
                        v0[0] += bf_lo(mm.x); v0[1] += bf_hi(mm.x); v0[2] += bf_lo(mm.y); v0[3] += bf_hi(mm.y);
                        v1[0] += bf_lo(mm.z); v1[1] += bf_hi(mm.z); v1[2] += bf_lo(mm.w); v1[3] += bf_hi(mm.w); }
                    u32x4 w; w.x = cvt_pk_bf16(v0[0], v0[1]); w.y = cvt_pk_bf16(v0[2], v0[3]); w.z = cvt_pk_bf16(v1[0], v1[1]); w.w = cvt_pk_bf16(v1[2], v1[3]);
                    *(u32x4*)op = w; } }
            asm volatile("" ::: "memory");
        }
    }
};

template <class Epi, class Sched, bool ALIGN_EPI = true, bool FP8 = false>
__device__ __forceinline__ void gemm_phase(LAS unsigned char* lds, const Gemm g, const Sched& S, const Epi& E) {
    int tid_ = threadIdx.x; asm volatile("" : "+v"(tid_));
    const int tid = tid_, wid = __builtin_amdgcn_readfirstlane(tid >> 6), lane = tid & 63, wr = wid >> 2, wc = wid & 3, fr = lane & 15, fq = lane >> 4;
    const int nt = g.K / BK;
    unsigned voffA[2], voffB[2];
#pragma unroll
    for (int i = 0; i < 2; ++i) { int R, C; stage_rc(tid * 16 + i * 8192, R, C); const int Rb = Epi::PERM ? ((R & ~31) + perm32(R & 31)) : R;
        voffA[i] = (unsigned)(R * g.lda + C) * 2u; voffB[i] = (unsigned)(Rb * g.ldb + C) * 2u; }
    const size_t kstep = (size_t)(BK * 2);
    const size_t hstepA = (size_t)HALF * g.lda * 2, hstepB = (size_t)HALF * g.ldb * 2;
    const size_t tstepA = 2 * hstepA, tstepB = 2 * hstepB;
    const unsigned ldsw = (unsigned)wid * 1024u;
    const int aoff = lds_byte(wr * 64 + fr, fq * 8), boff = lds_byte(wc * 32 + fr, fq * 8);
#define PG8_SA(b, h) (((b) * 2 + (h)) * HTB)
#define PG8_SB(b, h) ((4 + (b) * 2 + (h)) * HTB)
#define PG8_STAGE(bufoff, gbase, voff) do { _Pragma("unroll") for (int _i = 0; _i < 2; ++_i) \
        __builtin_amdgcn_global_load_lds((const unsigned*)((const char*)(gbase) + (voff)[_i]), (LAS unsigned*)(lds + (bufoff) + ldsw + _i * 8192), 16, 0, 0); } while (0)
#define PG8_LDA(dst, b, h) do { _Pragma("unroll") for (int m = 0; m < 4; ++m) { \
        if constexpr (FP8) { dst##8[m].lo = *(const LAS v4i*)(lds + PG8_SA(b, h) + aoff + m * 2048); dst##8[m].hi = *(const LAS v4i*)(lds + PG8_SA(b, h) + aoff + m * 2048 + 1024); } \
        else { _Pragma("unroll") for (int k = 0; k < 2; ++k) dst[m][k] = *(const LAS bf16x8*)(lds + PG8_SA(b, h) + aoff + m * 2048 + k * 1024); } } } while (0)
#define PG8_LDB(dst, b, h) do { _Pragma("unroll") for (int n = 0; n < 2; ++n) { \
        if constexpr (FP8) { dst##8[n].lo = *(const LAS v4i*)(lds + PG8_SB(b, h) + boff + n * 2048); dst##8[n].hi = *(const LAS v4i*)(lds + PG8_SB(b, h) + boff + n * 2048 + 1024); } \
        else { _Pragma("unroll") for (int k = 0; k < 2; ++k) dst[n][k] = *(const LAS bf16x8*)(lds + PG8_SB(b, h) + boff + n * 2048 + k * 1024); } } } while (0)
#define PG8_MMA(ai, bj, At, Bt) do { __builtin_amdgcn_s_setprio(1); _Pragma("unroll") for (int m = 0; m < 4; ++m) _Pragma("unroll") for (int n = 0; n < 2; ++n) { \
        if constexpr (FP8) asm volatile("v_mfma_scale_f32_16x16x128_f8f6f4 %0, %1, %2, %0, %3, %3 op_sel_hi:[0,0,0]" : "+v"(acc[ai][bj][m][n]) : "v"(Bt##8[n]), "v"(At##8[m]), "v"(sc7f)); \
        else { _Pragma("unroll") for (int k = 0; k < 2; ++k) acc[ai][bj][m][n] = __builtin_amdgcn_mfma_f32_16x16x32_bf16(Bt[n][k], At[m][k], acc[ai][bj][m][n], 0, 0, 0); } } \
        __builtin_amdgcn_s_setprio(0); } while (0)
#define PG8_WAIT_V(n) asm volatile("s_waitcnt vmcnt(" #n ")" ::: "memory")
#define PG8_WAIT_L(n) asm volatile("s_waitcnt lgkmcnt(" #n ")" ::: "memory")
#define PG8_BAR __builtin_amdgcn_s_barrier()
#define PG8_SCHED __builtin_amdgcn_sched_barrier(0)
    Unit cur, nxt; int ui = 0;
    if (!S.next(0, cur)) return;
    f32x4 acc[2][2][4][2];
#pragma unroll
    for (int a = 0; a < 2; ++a)
#pragma unroll
        for (int b = 0; b < 2; ++b)
#pragma unroll
            for (int m = 0; m < 4; ++m)
#pragma unroll
                for (int n = 0; n < 2; ++n) acc[a][b][m][n] = (f32x4){0.f, 0.f, 0.f, 0.f};
    const int sc7f = 0x7F7F7F7F;
    bf16x8 At[4][2], B0[2][2], B1[2][2];
    v8i At8[4], B08[2], B18[2];
    const char* cA = (const char*)g.A + (size_t)cur.pm * tstepA; const char* cB = (const char*)g.Bt + (size_t)cur.pn * tstepB;
    PG8_STAGE(PG8_SB(0, 0), cB, voffB); PG8_STAGE(PG8_SB(0, 1), cB + hstepB, voffB); PG8_STAGE(PG8_SA(0, 0), cA, voffA); PG8_STAGE(PG8_SA(0, 1), cA + hstepA, voffA);
    if (wr == 1) PG8_BAR;
    PG8_WAIT_V(2); PG8_BAR;
    PG8_STAGE(PG8_SB(1, 0), cB + kstep, voffB); PG8_STAGE(PG8_SA(1, 0), cA + kstep, voffA); PG8_STAGE(PG8_SB(1, 1), cB + hstepB + kstep, voffB);
    PG8_WAIT_V(6); PG8_BAR;
    for (;;) {
        const bool has_next = S.next(ui + 1, nxt);
        const char* nA = has_next ? (const char*)g.A + (size_t)nxt.pm * tstepA : cA; const char* nB = has_next ? (const char*)g.Bt + (size_t)nxt.pn * tstepB : cB;
        for (int t = 0; t < nt; t += 2) {
            const bool last = (t == nt - 2);
            const char* a1 = cA + (size_t)(t + 1) * kstep;
            const char* a2 = last ? nA : cA + (size_t)(t + 2) * kstep; const char* b2 = last ? nB : cB + (size_t)(t + 2) * kstep;
            const char* a3 = a2 + kstep; const char* b3 = b2 + kstep;
            PG8_LDB(B0, 0, 0); PG8_LDB(B1, 0, 1); PG8_SCHED; PG8_LDA(At, 0, 0); PG8_STAGE(PG8_SA(1, 1), a1 + hstepA, voffA);
            PG8_WAIT_V(8); PG8_WAIT_L(0); PG8_BAR; PG8_MMA(0, 0, At, B0); PG8_MMA(0, 1, At, B1); PG8_BAR; PG8_SCHED;
            PG8_LDA(At, 0, 1); PG8_STAGE(PG8_SB(0, 0), b2, voffB); PG8_STAGE(PG8_SB(0, 1), b2 + hstepB, voffB); PG8_STAGE(PG8_SA(0, 0), a2, voffA);
            PG8_WAIT_V(8); PG8_WAIT_L(0); PG8_BAR; PG8_MMA(1, 0, At, B0); PG8_MMA(1, 1, At, B1); PG8_BAR; PG8_SCHED;
            PG8_LDB(B0, 1, 0); PG8_LDB(B1, 1, 1); PG8_SCHED; PG8_LDA(At, 1, 0); PG8_STAGE(PG8_SA(0, 1), a2 + hstepA, voffA);
            PG8_WAIT_V(8); PG8_WAIT_L(0); PG8_BAR; PG8_MMA(0, 0, At, B0); PG8_MMA(0, 1, At, B1); PG8_BAR; PG8_SCHED;
            PG8_LDA(At, 1, 1); PG8_STAGE(PG8_SB(1, 0), b3, voffB); PG8_STAGE(PG8_SB(1, 1), b3 + hstepB, voffB); PG8_STAGE(PG8_SA(1, 0), a3, voffA);
            PG8_WAIT_V(8); PG8_WAIT_L(0); PG8_BAR; PG8_MMA(1, 0, At, B0); PG8_MMA(1, 1, At, B1); PG8_BAR; PG8_SCHED;
        }
        if constexpr (ALIGN_EPI) { if (wr == 0) PG8_BAR; }
        if constexpr (FP8) asm volatile("s_nop 15\n\ts_nop 15" ::: "memory");
        E(acc, cur, wr, wc, fr, fq);
        if (!has_next) break;
#pragma unroll
        for (int a = 0; a < 2; ++a)
#pragma unroll
            for (int b = 0; b < 2; ++b)
#pragma unroll
                for (int m = 0; m < 4; ++m)
#pragma unroll
                    for (int n = 0; n < 2; ++n) acc[a][b][m][n] = (f32x4){0.f, 0.f, 0.f, 0.f};
        cur = nxt; cA = nA; cB = nB; ++ui;
        if constexpr (ALIGN_EPI) { if (wr == 1) PG8_BAR; }
    }
    PG8_WAIT_V(0);
    if constexpr (!ALIGN_EPI) { if (wr == 0) PG8_BAR; }
    PG8_BAR;
#undef PG8_SA
#undef PG8_SB
#undef PG8_STAGE
#undef PG8_LDA
#undef PG8_LDB
#undef PG8_MMA
#undef PG8_WAIT_V
#undef PG8_WAIT_L
#undef PG8_BAR
#undef PG8_SCHED
}
}

namespace att {
constexpr int NW = 8, QBLK = 32, KVBLK = 64;
constexpr float SCALE = 0.088388347648318440f, INV_SCALE = 11.313708498984761f;
constexpr float THR = 8.f;
constexpr int SHM_V = KVBLK * 128 * 2, SHM_K = KVBLK * 128 * 2;
constexpr int OFF_WS = 2 * SHM_V + 2 * SHM_K, OFF_TAB = OFF_WS + NW * 64 * 4, TAB_STRIDE = 264, OFF_Q = OFF_TAB + 2 * TAB_STRIDE * 4, LDS_BYTES = OFF_Q + 16;
#define KSWZ(row, colB) ((row) * 256 + ((colB) ^ (((row) & 7) << 4)))
#define SBAR() __builtin_amdgcn_sched_barrier(0)
__device__ __forceinline__ int crow(int r, int hi) { return (r & 3) + 8 * (r >> 2) + 4 * hi; }

__device__ __forceinline__ void partialSM(f32x16& p0, f32x16& p1, float& m_reg, float& mn, float& alpha) {
  constexpr float C = SCALE * 1.4426950408889634f;
  float pmax = p0[0];
#pragma unroll
  for (int r = 1; r < 16; ++r) pmax = fmaxf(pmax, p0[r]);
#pragma unroll
  for (int r = 0; r < 16; ++r) pmax = fmaxf(pmax, p1[r]);
  { auto rr = __builtin_amdgcn_permlane32_swap(__float_as_uint(pmax), __float_as_uint(pmax), false, false);
    pmax = fmaxf(__uint_as_float(rr[0]), __uint_as_float(rr[1])); }
  if (__builtin_expect(__all(pmax - m_reg <= THR / SCALE), 1)) { mn = m_reg; alpha = 1.f; }
  else { mn = fmaxf(m_reg, pmax); alpha = __builtin_amdgcn_exp2f((m_reg - mn) * C); m_reg = mn; }
  float mnC = -mn * C;
#pragma unroll
  for (int r = 0; r < 16; ++r) p0[r] = fmaf(p0[r], C, mnC);
#pragma unroll
  for (int r = 0; r < 16; ++r) p1[r] = fmaf(p1[r], C, mnC);
#pragma unroll
  for (int r = 0; r < 16; ++r) p0[r] = __builtin_amdgcn_exp2f(p0[r]);
}
__device__ __forceinline__ void finishSM(f32x16& p0, f32x16& p1, float alpha, float& l_reg, bf16x8& pa0, bf16x8& pa1, bf16x8& pa2, bf16x8& pa3) {
#pragma unroll
  for (int r = 0; r < 16; ++r) p1[r] = __builtin_amdgcn_exp2f(p1[r]);
  float ps = 0;
#pragma unroll
  for (int r = 0; r < 16; ++r) ps += p0[r];
#pragma unroll
  for (int r = 0; r < 16; ++r) ps += p1[r];
  { auto rr = __builtin_amdgcn_permlane32_swap(__float_as_uint(ps), __float_as_uint(ps), false, false);
    ps = __uint_as_float(rr[0]) + __uint_as_float(rr[1]); }
  l_reg = l_reg * alpha + ps;
#define PK4(P, BASE, OUT) do { unsigned a0 = cvt_pk_bf16(P[BASE + 0], P[BASE + 1]), a1 = cvt_pk_bf16(P[BASE + 2], P[BASE + 3]);   \
    unsigned b0 = cvt_pk_bf16(P[BASE + 4], P[BASE + 5]), b1 = cvt_pk_bf16(P[BASE + 6], P[BASE + 7]);                              \
    auto r0 = __builtin_amdgcn_permlane32_swap(a0, b0, false, false); auto r1 = __builtin_amdgcn_permlane32_swap(a1, b1, false, false); \
    u32x4 w = {r0[0], r1[0], r0[1], r1[1]}; OUT = *reinterpret_cast<bf16x8*>(&w); } while (0)
  PK4(p0, 0, pa0); PK4(p0, 8, pa1); PK4(p1, 0, pa2); PK4(p1, 8, pa3);
#undef PK4
}
__device__ __forceinline__ void qkt(f32x16& p0, f32x16& p1, const bf16_t* Ks, const bf16x8* qr, int r32, int hi) {
  p0 = f32x16{}; p1 = f32x16{};
#pragma unroll
  for (int d0 = 0; d0 < 8; ++d0) { int cb = (d0 * 16 + hi * 8) * 2;
    bf16x8 b0 = *reinterpret_cast<const bf16x8*>((const char*)Ks + KSWZ(r32, cb));
    bf16x8 b1 = *reinterpret_cast<const bf16x8*>((const char*)Ks + KSWZ(32 + r32, cb));
    p0 = __builtin_amdgcn_mfma_f32_32x32x16_bf16(b0, qr[d0], p0, 0, 0, 0);
    p1 = __builtin_amdgcn_mfma_f32_32x32x16_bf16(b1, qr[d0], p1, 0, 0, 0); }
}
__device__ __forceinline__ void maskbias_half(f32x16& p, int kb, int qpos, int hw, int L, const float* tab, int hi) {
  float bv[16];
#pragma unroll
  for (int r = 0; r < 16; ++r) { const int ri = kb + crow(r, hi) - qpos + hw; bv[r] = tab[min(max(ri, 0), 2 * hw)]; }
#pragma unroll
  for (int r = 0; r < 16; ++r) asm volatile("" : "+v"(bv[r]));
#pragma unroll
  for (int r = 0; r < 16; ++r) { const int key = kb + crow(r, hi); const int ri = key - qpos + hw;
    const bool ok = ((unsigned)ri <= (unsigned)(2 * hw)) && ((unsigned)key < (unsigned)L);
    p[r] = ok ? p[r] + bv[r] : -1e30f; }
}
__device__ __forceinline__ void maskbias(f32x16& p0, f32x16& p1, int kbase, int qpos, int hw, int L, const float* tab, int hi) {
  maskbias_half(p0, kbase, qpos, hw, L, tab, hi); maskbias_half(p1, kbase + 32, qpos, hw, L, tab, hi);
}
__device__ __forceinline__ int v_st(int k, int c) { const int kk = (k & ~0xC) | ((k & 4) << 1) | ((k & 8) >> 1); return ((kk >> 3) * 4 + (c >> 5)) * 512 + ((kk & 7) * 32 + (c & 31)) * 2; }
__device__ __forceinline__ int v_rd_base(int lane) { return ((lane & 3) << 3) | (((lane >> 2) & 3) << 6) | (((lane >> 4) & 1) << 5) | (((lane >> 5) & 1) << 8); }
constexpr int v_rd_off(int d0, int ks, int half) { return d0 * 512 + ks * 4096 + half * 2048; }
template <int OFF> __device__ __forceinline__ s16x4 tr_read(int vb) {
  s16x4 r; asm volatile("ds_read_b64_tr_b16 %0, %1 offset:%2" : "=&v"(r) : "v"(vb), "i"(OFF) : "memory"); return r;
}
template <int D0> __device__ __forceinline__ void pv_one(f32x16& od, int vb, bf16x8 pa0, bf16x8 pa1, bf16x8 pa2, bf16x8 pa3) {
  const s16x4 l0 = tr_read<v_rd_off(D0, 0, 0)>(vb), h0 = tr_read<v_rd_off(D0, 0, 1)>(vb), l1 = tr_read<v_rd_off(D0, 1, 0)>(vb), h1 = tr_read<v_rd_off(D0, 1, 1)>(vb);
  const s16x4 l2 = tr_read<v_rd_off(D0, 2, 0)>(vb), h2 = tr_read<v_rd_off(D0, 2, 1)>(vb), l3 = tr_read<v_rd_off(D0, 3, 0)>(vb), h3 = tr_read<v_rd_off(D0, 3, 1)>(vb);
  asm volatile("s_waitcnt lgkmcnt(0)" ::: "memory"); SBAR();
#define PK(L, H) (bf16x8){L[0], L[1], L[2], L[3], H[0], H[1], H[2], H[3]}
  od = __builtin_amdgcn_mfma_f32_32x32x16_bf16(pa0, PK(l0, h0), od, 0, 0, 0);
  od = __builtin_amdgcn_mfma_f32_32x32x16_bf16(pa1, PK(l1, h1), od, 0, 0, 0);
  od = __builtin_amdgcn_mfma_f32_32x32x16_bf16(pa2, PK(l2, h2), od, 0, 0, 0);
  od = __builtin_amdgcn_mfma_f32_32x32x16_bf16(pa3, PK(l3, h3), od, 0, 0, 0);
#undef PK
}
__device__ __forceinline__ void pv_d0(f32x16* o, int vb, bf16x8 pa0, bf16x8 pa1, bf16x8 pa2, bf16x8 pa3) {
  pv_one<0>(o[0], vb, pa0, pa1, pa2, pa3); pv_one<1>(o[1], vb, pa0, pa1, pa2, pa3); pv_one<2>(o[2], vb, pa0, pa1, pa2, pa3); pv_one<3>(o[3], vb, pa0, pa1, pa2, pa3);
}

struct AttnP {
  const bf16_t* Qw;
  const bf16_t* Kb; const bf16_t* Vb;
  long ks;
  int k0, NT, L;
  int qpos, hw;
  const float* tab;
  float sink; int has_sink;
  int omode;
  bf16_t* Yp; long ys;
  float* Cp; long cs; float* Lp; long ls;
};

#ifndef ATT_SDEPTH
#define ATT_SDEPTH 1
#endif
template <int MODE>
__device__ __forceinline__ void attn_body(const AttnP& P, char* lds) {
  int tid_ = threadIdx.x; asm volatile("" : "+v"(tid_));
  const int tid = tid_, wid = tid >> 6, lane = tid & 63, r32 = lane & 31, hi = lane >> 5;
  bf16_t* V_lds = (bf16_t*)lds; bf16_t* K_lds = (bf16_t*)(lds + 2 * SHM_V);
  float* ws = (float*)(lds + OFF_WS) + wid * 64; float* li_l = ws; float* al_l = ws + 32;
  float m_reg = -1e4f, l_reg = 0; f32x16 o[4] = {}; bf16x8 qr[8];
#pragma unroll
  for (int d0 = 0; d0 < 8; ++d0) qr[d0] = *reinterpret_cast<const bf16x8*>(P.Qw + d0 * 16);
  const int sr = tid >> 4, sc = (tid & 15) * 8, vst0 = v_st(sr, sc), vst1 = v_st(32 + sr, sc);
  const int vb0 = (int)(uintptr_t)V_lds + v_rd_base(lane);
  constexpr int SDEPTH = ATT_SDEPTH;
  struct { bf16x8 vs0, vs1, ks0, ks1; } sr_[SDEPTH];
#define KROW(kp) (MODE ? min(max((kp), 0), P.L - 1) : (kp))
#define SLOAD(i, t_) do { const int kk0_ = P.k0 + (t_) * KVBLK; const long ra_ = (long)KROW(kk0_ + sr) * (MODE ? P.ks : (long)3840) + sc, rb_ = (long)KROW(kk0_ + 32 + sr) * (MODE ? P.ks : (long)3840) + sc; \
    sr_[i].vs0 = *reinterpret_cast<const bf16x8*>(P.Vb + ra_); sr_[i].vs1 = *reinterpret_cast<const bf16x8*>(P.Vb + rb_); \
    sr_[i].ks0 = *reinterpret_cast<const bf16x8*>(P.Kb + ra_); sr_[i].ks1 = *reinterpret_cast<const bf16x8*>(P.Kb + rb_); } while (0)
#define SWRITE(b, i) do { *(bf16x8*)((char*)V_lds + (b) * SHM_V + vst0) = sr_[i].vs0;          \
    *(bf16x8*)((char*)V_lds + (b) * SHM_V + vst1) = sr_[i].vs1; int kc = sc * 2;               \
    *(bf16x8*)((char*)K_lds + (b) * SHM_K + KSWZ(sr, kc)) = sr_[i].ks0;                       \
    *(bf16x8*)((char*)K_lds + (b) * SHM_K + KSWZ(32 + sr, kc)) = sr_[i].ks1; } while (0)
#define SWAIT() do { if constexpr (SDEPTH == 2) asm volatile("s_waitcnt vmcnt(4)" ::: "memory"); else asm volatile("s_waitcnt vmcnt(0)" ::: "memory"); } while (0)
#define RESC(a) do { if (__any((a) < 1.f)) { if (hi == 0) al_l[r32] = (a); asm volatile("s_waitcnt lgkmcnt(0)" ::: "memory"); \
    _Pragma("unroll") for (int d = 0; d < 4; ++d) _Pragma("unroll") for (int r = 0; r < 16; ++r) o[d][r] *= al_l[crow(r, hi)]; } } while (0)
#define MB(p0_, p1_, t_) do { if (MODE) maskbias(p0_, p1_, P.k0 + (t_) * KVBLK, P.qpos, P.hw, P.L, P.tab, hi); } while (0)
  f32x16 pA0, pA1, pB0, pB1; float mnA, mnB, alA, alB; bf16x8 pa0, pa1, pa2, pa3; const int NT = P.NT;
  constexpr int SE = 0, SO = SDEPTH - 1;
  SLOAD(SE, 0); asm volatile("s_waitcnt vmcnt(0)" ::: "memory"); SWRITE(0, SE); __syncthreads();
  qkt(pA0, pA1, K_lds, qr, r32, hi); MB(pA0, pA1, 0); partialSM(pA0, pA1, m_reg, mnA, alA);
  constexpr bool EARLY = (SDEPTH == 1);
  SLOAD(SO, 1); if constexpr (SDEPTH == 2) { if (2 < NT) SLOAD(SE, 2); }
  SWAIT(); SWRITE(1, SO); if constexpr (EARLY) { if (2 < NT) SLOAD(SE, 2); } __syncthreads();
  for (int j = 1; j + 1 < NT; j += 2) {
    SBAR(); qkt(pB0, pB1, (bf16_t*)((char*)K_lds + SHM_K), qr, r32, hi); MB(pB0, pB1, j);
    finishSM(pA0, pA1, alA, l_reg, pa0, pa1, pa2, pa3); SBAR();
    if constexpr (!EARLY) { SLOAD(SO, (j + SDEPTH < NT) ? j + SDEPTH : j); } SBAR();
    pv_d0(o, vb0, pa0, pa1, pa2, pa3); partialSM(pB0, pB1, m_reg, mnB, alB);
    __syncthreads(); SWAIT(); SWRITE(0, SE); if constexpr (EARLY) { if (j + 2 < NT) SLOAD(SO, j + 2); }
    RESC(alB); __syncthreads();
    SBAR(); qkt(pA0, pA1, K_lds, qr, r32, hi); MB(pA0, pA1, j + 1);
    finishSM(pB0, pB1, alB, l_reg, pa0, pa1, pa2, pa3); SBAR();
    if constexpr (!EARLY) { if (j + 3 < NT) SLOAD(SE, j + 1 + SDEPTH); } SBAR();
    pv_d0(o, vb0 + (int)SHM_V, pa0, pa1, pa2, pa3); partialSM(pA0, pA1, m_reg, mnA, alA);
    __syncthreads(); SWAIT(); SWRITE(1, SO); if constexpr (EARLY) { if (j + 3 < NT) SLOAD(SE, j + 3); }
    RESC(alA); __syncthreads();
  }
  SBAR(); qkt(pB0, pB1, (bf16_t*)((char*)K_lds + SHM_K), qr, r32, hi); MB(pB0, pB1, NT - 1);
  finishSM(pA0, pA1, alA, l_reg, pa0, pa1, pa2, pa3); SBAR();
  pv_d0(o, vb0, pa0, pa1, pa2, pa3); partialSM(pB0, pB1, m_reg, mnB, alB);
  __syncthreads(); RESC(alB);
  finishSM(pB0, pB1, alB, l_reg, pa0, pa1, pa2, pa3); SBAR();
  pv_d0(o, vb0 + (int)SHM_V, pa0, pa1, pa2, pa3);
  asm volatile("s_waitcnt vmcnt(0)" ::: "memory");
  if (MODE) { if (P.has_sink) l_reg += __builtin_amdgcn_exp2f((P.sink - m_reg * SCALE) * LOG2E); }
  if (hi == 0) li_l[r32] = l_reg; asm volatile("s_waitcnt lgkmcnt(0)" ::: "memory");
  float rli[16];
#pragma unroll
  for (int r = 0; r < 16; ++r) rli[r] = __builtin_amdgcn_rcpf(li_l[crow(r, hi)]);
  if (!MODE || P.omode == 0) {
#pragma unroll
    for (int r = 0; r < 16; ++r) { const int orow = crow(r, hi);
#pragma unroll
      for (int d0 = 0; d0 < 4; ++d0) P.Yp[(long)orow * (MODE ? P.ys : (long)1536) + d0 * 32 + r32] = (bf16_t)(cvt_pk_bf16(o[d0][r] * rli[r], 0.f) & 0xffffu); }
  } else {
#pragma unroll
    for (int r = 0; r < 16; ++r) { const int orow = crow(r, hi);
#pragma unroll
      for (int d0 = 0; d0 < 4; ++d0) P.Cp[(long)orow * P.cs + d0 * 32 + r32] = o[d0][r] * rli[r]; }
    if (hi == 0) P.Lp[(long)r32 * P.ls] = m_reg * SCALE + __logf(l_reg);
  }
#undef KROW
#undef SLOAD
#undef SWRITE
#undef SWAIT
#undef RESC
#undef MB
}

__device__ __forceinline__ void attn_banded(const AttnP& P, char* lds) {
  int tid_ = threadIdx.x; asm volatile("" : "+v"(tid_));
  const int tid = tid_, wid = tid >> 6, lane = tid & 63, r32 = lane & 31, hi = lane >> 5;
  bf16_t* V_lds = (bf16_t*)lds; bf16_t* K_lds = (bf16_t*)(lds + 2 * SHM_V);
  float* ws = (float*)(lds + OFF_WS) + wid * 64; float* li_l = ws; float* al_l = ws + 32;
  float m_reg = -1e4f, l_reg = 0; f32x16 o[4] = {}; bf16x8 qr[8];
#pragma unroll
  for (int d0 = 0; d0 < 8; ++d0) qr[d0] = *reinterpret_cast<const bf16x8*>(P.Qw + d0 * 16);
  const int sr = tid >> 4, sc = (tid & 15) * 8, vst0 = v_st(sr, sc), vst1 = v_st(32 + sr, sc);
  const int vb0 = (int)(uintptr_t)V_lds + v_rd_base(lane);
  bf16x8 vs0, vs1, ks0, ks1;
#define KROW(kp) min(max((kp), 0), P.L - 1)
#define SLOAD(t_) do { const int kk0_ = P.k0 + (t_) * KVBLK; const long ra_ = (long)KROW(kk0_ + sr) * P.ks + sc, rb_ = (long)KROW(kk0_ + 32 + sr) * P.ks + sc; \
    vs0 = *reinterpret_cast<const bf16x8*>(P.Vb + ra_); vs1 = *reinterpret_cast<const bf16x8*>(P.Vb + rb_); \
    ks0 = *reinterpret_cast<const bf16x8*>(P.Kb + ra_); ks1 = *reinterpret_cast<const bf16x8*>(P.Kb + rb_); } while (0)
#define SWRITE(b) do { *(bf16x8*)((char*)V_lds + (b) * SHM_V + vst0) = vs0; *(bf16x8*)((char*)V_lds + (b) * SHM_V + vst1) = vs1; const int kc = sc * 2; \
    *(bf16x8*)((char*)K_lds + (b) * SHM_K + KSWZ(sr, kc)) = ks0; *(bf16x8*)((char*)K_lds + (b) * SHM_K + KSWZ(32 + sr, kc)) = ks1; } while (0)
  SLOAD(0); asm volatile("s_waitcnt vmcnt(0)" ::: "memory"); SWRITE(0);
  const int NT = P.NT;
  for (int t = 0; t < NT; ++t) {
    const int b = t & 1;
    if (t + 1 < NT) SLOAD(t + 1);
    __syncthreads();
    f32x16 p0, p1; float mn, al; bf16x8 pa0, pa1, pa2, pa3;
    qkt(p0, p1, (bf16_t*)((char*)K_lds + b * SHM_K), qr, r32, hi);
    maskbias(p0, p1, P.k0 + t * KVBLK, P.qpos, P.hw, P.L, P.tab, hi);
    partialSM(p0, p1, m_reg, mn, al);
    if (__any(al < 1.f)) { if (hi == 0) al_l[r32] = al; asm volatile("s_waitcnt lgkmcnt(0)" ::: "memory");
#pragma unroll
      for (int d = 0; d < 4; ++d)
#pragma unroll
        for (int r = 0; r < 16; ++r) o[d][r] *= al_l[crow(r, hi)]; }
    finishSM(p0, p1, al, l_reg, pa0, pa1, pa2, pa3); SBAR();
    pv_d0(o, vb0 + b * (int)SHM_V, pa0, pa1, pa2, pa3);
    if (t + 1 < NT) { asm volatile("s_waitcnt vmcnt(0)" ::: "memory"); SWRITE(b ^ 1); }
  }
  if (P.has_sink) l_reg += __builtin_amdgcn_exp2f((P.sink - m_reg * SCALE) * LOG2E);
  if (hi == 0) li_l[r32] = l_reg; asm volatile("s_waitcnt lgkmcnt(0)" ::: "memory");
  float rli[16];
#pragma unroll
  for (int r = 0; r < 16; ++r) rli[r] = __builtin_amdgcn_rcpf(li_l[crow(r, hi)]);
  if (P.omode == 0) {
#pragma unroll
    for (int r = 0; r < 16; ++r) { const int orow = crow(r, hi);
#pragma unroll
      for (int d0 = 0; d0 < 4; ++d0) P.Yp[(long)orow * P.ys + d0 * 32 + r32] = (bf16_t)(cvt_pk_bf16(o[d0][r] * rli[r], 0.f) & 0xffffu); }
  } else {
#pragma unroll
    for (int r = 0; r < 16; ++r) { const int orow = crow(r, hi);
#pragma unroll
      for (int d0 = 0; d0 < 4; ++d0) P.Cp[(long)orow * P.cs + d0 * 32 + r32] = o[d0][r] * rli[r]; }
    if (hi == 0) P.Lp[(long)r32 * P.ls] = m_reg * SCALE + __logf(l_reg);
  }
#undef KROW
#undef SLOAD
#undef SWRITE
}
}

constexpr size_t MiB = 1u << 20;
constexpr size_t WS_CTL = 0, WS_W13A = 1 * MiB, WS_W2A = 45 * MiB, WS_WIN = 67 * MiB, WS_WG = 82 * MiB, WS_WBR = 106 * MiB, WS_WO = 112 * MiB,
                 WS_W13B = 120 * MiB, WS_W2B = 164 * MiB, WS_H = 186 * MiB, WS_R1 = 250 * MiB, WS_Z = WS_R1, WS_Y = 370 * MiB, WS_MRG = 418 * MiB,
                 WS_HID = WS_R1, WS_CO = WS_MRG, WS_CLSE = WS_MRG + 48 * MiB, WS_GATES = 482 * MiB, WS_XB8 = 674 * MiB, WS_WG8 = 706 * MiB, WS_END = 718 * MiB;
constexpr int RING_BYTES = 131072, LDS_BYTES = 147456;
static_assert(att::LDS_BYTES <= RING_BYTES, "attention LDS fits in the ring");

struct Params { const float* in[21]; float* out; unsigned char* ws; };

__device__ __forceinline__ float wave_sum(float v) {
#pragma unroll
    for (int o = 1; o < 64; o <<= 1) v += __shfl_xor(v, o);
    return v;
}

__device__ __forceinline__ void cvt_item(const float* __restrict__ W, int N, bf16_t* __restrict__ WT, int ldw, int koff, int mode, LAS float* scr, int item, int lane, const float* __restrict__ gain = nullptr) {
    const int nblk = N / 32, kb = item / nblk, nb = item - kb * nblk, k0 = 64 * kb, n0 = 32 * nb;
    const int lr = lane >> 3, lc = (lane & 7) * 4;
    f32x4 v[8];
#pragma unroll
    for (int i = 0; i < 8; ++i) v[i] = *(const f32x4*)(W + (size_t)(k0 + 8 * i + lr) * N + n0 + lc);
#pragma unroll
    for (int i = 0; i < 8; ++i) { const float gk = gain ? gain[k0 + 8 * i + lr] : 1.0f; LAS float* s = scr + (8 * i + lr) * 33 + lc; s[0] = v[i].x * gk; s[1] = v[i].y * gk; s[2] = v[i].z * gk; s[3] = v[i].w * gk; }
    LDS_WAIT();
    int drow0 = n0;
    if (mode == 1) { const int bj = n0 / DFF, rem = n0 - bj * DFF, pn = rem >> 7, c = rem & 127; drow0 = 256 * pn + 128 * bj + c; }
    const int c = lane & 7;
#pragma unroll
    for (int j = 0; j < 4; ++j) { const int n = (lane >> 3) + 8 * j; const LAS float* s = scr + (8 * c) * 33 + n;
        u32x4 o; o.x = cvt_pk_bf16(s[0 * 33], s[1 * 33]); o.y = cvt_pk_bf16(s[2 * 33], s[3 * 33]); o.z = cvt_pk_bf16(s[4 * 33], s[5 * 33]); o.w = cvt_pk_bf16(s[6 * 33], s[7 * 33]);
        *(u32x4*)(WT + (size_t)(drow0 + n) * ldw + koff + k0 + 8 * c) = o; }
    LDS_WAIT();
}


__device__ __forceinline__ u32x2 cvt8_fp8(float a0, float a1, float a2, float a3, float a4, float a5, float a6, float a7) {
    int w0 = __builtin_amdgcn_cvt_pk_fp8_f32(a0, a1, 0, false); w0 = __builtin_amdgcn_cvt_pk_fp8_f32(a2, a3, w0, true);
    int w1 = __builtin_amdgcn_cvt_pk_fp8_f32(a4, a5, 0, false); w1 = __builtin_amdgcn_cvt_pk_fp8_f32(a6, a7, w1, true);
    u32x2 r; r.x = (unsigned)w0; r.y = (unsigned)w1; return r;
}
constexpr float WG8_SCALE = 64.0f;
__device__ __forceinline__ void cvt_item_fp8(const float* __restrict__ W, int N, unsigned char* __restrict__ WT, int ldw, LAS float* scr, int item, int lane, const float* __restrict__ gain) {
    const int nblk = N / 32, kb = item / nblk, nb = item - kb * nblk, k0 = 64 * kb, n0 = 32 * nb;
    const int lr = lane >> 3, lc = (lane & 7) * 4;
    f32x4 v[8];
#pragma unroll
    for (int i = 0; i < 8; ++i) v[i] = *(const f32x4*)(W + (size_t)(k0 + 8 * i + lr) * N + n0 + lc);
#pragma unroll
    for (int i = 0; i < 8; ++i) { const float gk = gain[k0 + 8 * i + lr] * WG8_SCALE; LAS float* s = scr + (8 * i + lr) * 33 + lc; s[0] = v[i].x * gk; s[1] = v[i].y * gk; s[2] = v[i].z * gk; s[3] = v[i].w * gk; }
    LDS_WAIT();
    const int c = lane & 7;
#pragma unroll
    for (int j = 0; j < 4; ++j) { const int n = (lane >> 3) + 8 * j; const LAS float* s = scr + (8 * c) * 33 + n;
        *(u32x2*)(WT + (size_t)(n0 + n) * ldw + k0 + 8 * c) = cvt8_fp8(s[0 * 33], s[1 * 33], s[2 * 33], s[3 * 33], s[4 * 33], s[5 * 33], s[6 * 33], s[7 * 33]); }
    LDS_WAIT();
}

template <bool COPY>
__device__ __forceinline__ void rms_row_bf16(const float* __restrict__ xrow, const float* __restrict__ gain, bf16_t* __restrict__ orow, float* __restrict__ xcopy, int lane) {
    const f32x4* xr = (const f32x4*)xrow + lane;
    f32x4 v[8]; float s = 0.f;
#pragma unroll
    for (int j = 0; j < 8; ++j) { v[j] = xr[64 * j]; s += (v[j].x * v[j].x + v[j].y * v[j].y) + (v[j].z * v[j].z + v[j].w * v[j].w); }
    if (COPY) {
#pragma unroll
        for (int j = 0; j < 8; ++j) ((f32x4*)xcopy + lane)[64 * j] = v[j]; }
    const float rs = 1.0f / sqrtf(wave_sum(s) * (1.f / DM) + NORM_EPS);
    const f32x4* gr = (const f32x4*)gain + lane;
    u32x2* o8 = (u32x2*)orow + lane;
#pragma unroll
    for (int j = 0; j < 8; ++j) { const f32x4 g = gr[64 * j]; u32x2 w; w.x = cvt_pk_bf16(v[j].x * rs * g.x, v[j].y * rs * g.y); w.y = cvt_pk_bf16(v[j].z * rs * g.z, v[j].w * rs * g.w); o8[64 * j] = w; }
}
__device__ __forceinline__ void x_row_init(const float* __restrict__ xrow, float* __restrict__ xcopy, bf16_t* __restrict__ xb, float* __restrict__ ssq_row, int lane) {
    const f32x4* xr = (const f32x4*)xrow + lane;
    f32x4 v[8]; float s = 0.f;
#pragma unroll
    for (int j = 0; j < 8; ++j) { v[j] = xr[64 * j]; s += (v[j].x * v[j].x + v[j].y * v[j].y) + (v[j].z * v[j].z + v[j].w * v[j].w); }
#pragma unroll
    for (int j = 0; j < 8; ++j) ((f32x4*)xcopy + lane)[64 * j] = v[j];
    u32x2* o8 = (u32x2*)xb + lane;
#pragma unroll
    for (int j = 0; j < 8; ++j) { u32x2 w; w.x = cvt_pk_bf16(v[j].x, v[j].y); w.y = cvt_pk_bf16(v[j].z, v[j].w); o8[64 * j] = w; }
    s = wave_sum(s);
    if (lane == 0) *ssq_row = s;
}
__device__ __forceinline__ void rms_row_f32(float* __restrict__ xrow, const float* __restrict__ gain, int lane) {
    f32x4* xr = (f32x4*)xrow + lane;
    f32x4 v[8]; float s = 0.f;
#pragma unroll
    for (int j = 0; j < 8; ++j) { v[j] = xr[64 * j]; s += (v[j].x * v[j].x + v[j].y * v[j].y) + (v[j].z * v[j].z + v[j].w * v[j].w); }
    const float rs = 1.0f / sqrtf(wave_sum(s) * (1.f / DM) + NORM_EPS);
    const f32x4* gr = (const f32x4*)gain + lane;
#pragma unroll
    for (int j = 0; j < 8; ++j) { const f32x4 g = gr[64 * j]; f32x4 w; w.x = v[j].x * rs * g.x; w.y = v[j].y * rs * g.y; w.z = v[j].z * rs * g.z; w.w = v[j].w * rs * g.w; xr[64 * j] = w; }
}

__device__ __forceinline__ int t5_bucket(int rel) {
    const int n = rel < 0 ? -rel : rel;
    int b = n;
    if (n >= 8) { b = 5 + (31 - __clz(n)); b = b < 15 ? b : 15; }
    return (rel > 0 ? 16 : 0) + b;
}


#define XB_TMO      128
#define XB_XCNT(j)  (256  + 64 * (j))
#define XB_XSUB(j)  (1280 + 64 * (j))
#define XB_XGEN(j)  (2304 + 64 * (j))
#define XB_TOP      3328
#define XB_TOPGEN   3392
#define XCD_BAR_WORDS 3456
#define XB_SPIN_CAP (1u << 18)

__device__ __forceinline__ unsigned xb_ld(unsigned* p)              { return __hip_atomic_load(p, __ATOMIC_RELAXED, __HIP_MEMORY_SCOPE_AGENT); }
__device__ __forceinline__ unsigned xb_add(unsigned* p, unsigned v) { return __hip_atomic_fetch_add(p, v, __ATOMIC_RELAXED, __HIP_MEMORY_SCOPE_AGENT); }
__device__ __forceinline__ unsigned xb_xcc_id() { return (unsigned)__builtin_amdgcn_s_getreg((3 << 11) | 20) & 0xFu; }
#define XB_SPIN(cond, bar) do { unsigned _sp = 0; while (cond) { __builtin_amdgcn_s_sleep(1); \
    if ((++_sp & 255u) == 0u) { if (xb_ld(&(bar)[XB_TMO])) break; if (_sp > XB_SPIN_CAP) { atomicAdd(&(bar)[XB_TMO], 1u); break; } } } } while (0)

struct XcdBarrier {
    unsigned* bar; unsigned x;
    volatile LAS unsigned* st;
};

__device__ __forceinline__ XcdBarrier xcd_barrier_post(unsigned* bar, volatile LAS unsigned* st) {
    XcdBarrier b; b.bar = bar; b.x = xb_xcc_id(); b.st = st;
    if (threadIdx.x == 0) (void)xb_add(&bar[XB_XCNT(b.x)], 1u);
    return b;
}
__device__ __forceinline__ void xcd_barrier_complete(unsigned* bar, unsigned x, unsigned& nloc, unsigned& nx) {
    const unsigned G = gridDim.x * gridDim.y * gridDim.z;
    unsigned sum, cnt, mine, sp = 0u;
    for (;;) {
        sum = 0u; cnt = 0u; mine = 0u;
#pragma unroll
        for (unsigned j = 0; j < 16; ++j) { const unsigned c = xb_ld(&bar[XB_XCNT(j)]); sum += c; cnt += (c > 0u) ? 1u : 0u; mine = (j == x) ? c : mine; }
        if (sum == G) break;
        __builtin_amdgcn_s_sleep(1);
        if ((++sp & 255u) == 0u) { if (xb_ld(&bar[XB_TMO])) break; if (sp > XB_SPIN_CAP) { atomicAdd(&bar[XB_TMO], 1u); break; } }
    }
    nloc = mine > 0u ? mine : 1u; nx = cnt > 0u ? cnt : 1u;
}

__device__ __forceinline__ void xcd_barrier(const XcdBarrier& b) {
    asm volatile("s_waitcnt vmcnt(0)" ::: "memory");
    __syncthreads();
    if (threadIdx.x == 0) {
        unsigned* bar = b.bar;
        __builtin_amdgcn_s_waitcnt(0);
        unsigned nloc = b.st[0], nx = b.st[1];
        if (nloc == 0u) { xcd_barrier_complete(bar, b.x, nloc, nx); b.st[0] = nloc; b.st[1] = nx; }
        const unsigned old = xb_add(&bar[XB_XSUB(b.x)], 1u);
        const unsigned gen = old / nloc;
        if (old + 1u == (gen + 1u) * nloc) {
            __builtin_amdgcn_fence(__ATOMIC_RELEASE, "agent");
            asm volatile("s_waitcnt vmcnt(0)" ::: "memory");
            const unsigned og = xb_add(&bar[XB_TOP], 1u);
            const unsigned tg = og / nx;
            if (og + 1u == (tg + 1u) * nx) xb_add(&bar[XB_TOPGEN], 1u);
            else XB_SPIN(xb_ld(&bar[XB_TOPGEN]) == tg, bar);
            __builtin_amdgcn_fence(__ATOMIC_ACQUIRE, "agent");
            xb_add(&bar[XB_XGEN(b.x)], 1u);
            asm volatile("s_waitcnt vmcnt(0)" ::: "memory");
        } else {
            XB_SPIN(xb_ld(&bar[XB_XGEN(b.x)]) == gen, bar);
            __builtin_amdgcn_fence(__ATOMIC_ACQUIRE, "agent");
            asm volatile("s_waitcnt vmcnt(0)" ::: "memory");
        }
    }
    __syncthreads();
}


#define GSYNC() xcd_barrier(xbar)


template <int layer>
__device__ __forceinline__ void run_layer(const Params& p, unsigned char* lds, const XcdBarrier& xbar) {
    int tid_ = threadIdx.x; asm volatile("" : "+v"(tid_));
    const int tid = tid_, lane = tid & 63, wave = __builtin_amdgcn_readfirstlane(tid >> 6);
    const int G = gridDim.x, gw = blockIdx.x * 8 + wave, NGW = G * 8;
    unsigned char* ws = p.ws;
    unsigned* ctl = (unsigned*)(ws + WS_CTL);
    bf16_t* H = (bf16_t*)(ws + WS_H); bf16_t* Z = (bf16_t*)(ws + WS_Z); bf16_t* Y = (bf16_t*)(ws + WS_Y); bf16_t* MRG = (bf16_t*)(ws + WS_MRG);
    bf16_t* HID = (bf16_t*)(ws + WS_HID); bf16_t* GATES = (bf16_t*)(ws + WS_GATES); float* CO = (float*)(ws + WS_CO); float* CLSE = (float*)(ws + WS_CLSE);
    bf16_t* W13A = (bf16_t*)(ws + WS_W13A); bf16_t* W2A = (bf16_t*)(ws + WS_W2A); bf16_t* WIN = (bf16_t*)(ws + WS_WIN); unsigned char* WG8 = ws + WS_WG8; unsigned char* XB8 = ws + WS_XB8;
    bf16_t* WBR = (bf16_t*)(ws + WS_WBR); bf16_t* WO = (bf16_t*)(ws + WS_WO); bf16_t* W13B = (bf16_t*)(ws + WS_W13B); bf16_t* W2B = (bf16_t*)(ws + WS_W2B);
    float* X = p.out;
    LAS unsigned char* ldsl = (LAS unsigned char*)lds;
    float* SSQ = (float*)(ws + 65536);
    float* ssqA = SSQ + (size_t)(3 * layer) * MTOK; float* ssqB = ssqA + MTOK; float* ssqC = ssqB + MTOK; float* ssqN = ssqC + MTOK;
    {
        {
            LAS float* scr = (LAS float*)(ldsl + wave * 16384);
            const float* s_w13a = p.in[3] + (size_t)layer * DM * 2 * DFF; const float* s_w2a = p.in[4] + (size_t)layer * DFF * DM;
            const float* s_win = p.in[6] + (size_t)layer * DM * NIN; const float* s_wg = p.in[10] + (size_t)layer * DM * NG;
            const float* s_bra = p.in[12] + (size_t)layer * 512 * DM; const float* s_brb = p.in[13] + (size_t)layer * 768 * DM; const float* s_brc = p.in[14] + (size_t)layer * 256 * DM;
            const float* s_wo = p.in[15] + (size_t)layer * DM * DM;
            const float* s_w13b = p.in[17] + (size_t)layer * DM * 2 * DFF; const float* s_w2b = p.in[18] + (size_t)layer * DFF * DM;
            constexpr int I_13 = (DM / 64) * (2 * DFF / 32), I_2 = (DFF / 64) * (DM / 32), I_IN = (DM / 64) * (NIN / 32), I_G = (DM / 64) * (NG / 32),
                          I_BA = (512 / 64) * (DM / 32), I_BB = (768 / 64) * (DM / 32), I_BC = (256 / 64) * (DM / 32), I_O = (DM / 64) * (DM / 32);
            constexpr int NITEMS = 2 * I_13 + 2 * I_2 + I_IN + I_G + I_BA + I_BB + I_BC + I_O;
            for (int it = gw; it < NITEMS; it += NGW) {
                int r = it;
                if (r < I_13) { cvt_item(s_w13a, 2 * DFF, W13A, DM, 0, 1, scr, r, lane, p.in[2] + (size_t)layer * DM); continue; } r -= I_13;
                if (r < I_2) { cvt_item(s_w2a, DM, W2A, DFF, 0, 0, scr, r, lane); continue; } r -= I_2;
                if (r < I_IN) { cvt_item(s_win, NIN, WIN, DM, 0, 0, scr, r, lane, p.in[5] + (size_t)layer * DM); continue; } r -= I_IN;
                if (r < I_G) { cvt_item_fp8(s_wg, NG, WG8, DM, scr, r, lane, p.in[5] + (size_t)layer * DM); continue; } r -= I_G;
                if (r < I_BA) { cvt_item(s_bra, DM, WBR, NY, 0, 0, scr, r, lane); continue; } r -= I_BA;
                if (r < I_BB) { cvt_item(s_brb, DM, WBR, NY, 512, 0, scr, r, lane); continue; } r -= I_BB;
                if (r < I_BC) { cvt_item(s_brc, DM, WBR, NY, 1280, 0, scr, r, lane); continue; } r -= I_BC;
                if (r < I_O) { cvt_item(s_wo, DM, WO, DM, 0, 0, scr, r, lane); continue; } r -= I_O;
                if (r < I_13) { cvt_item(s_w13b, 2 * DFF, W13B, DM, 0, 1, scr, r, lane, p.in[16] + (size_t)layer * DM); continue; } r -= I_13;
                cvt_item(s_w2b, DM, W2B, DFF, 0, 0, scr, r, lane);
            }
            if (layer == 0) {
                for (int m = gw; m < MTOK; m += NGW) { const float* src = m < 8192 ? p.in[0] + (size_t)m * DM : p.in[1] + (size_t)(m - 8192) * DM;
                    x_row_init(src, X + (size_t)m * DM, H + (size_t)m * DM, ssqA + m, lane); }
            }
        }
        GSYNC();
        { pg8::Gemm g{H, W13A, MTOK, 2 * DFF, DM, DM, DM}; pg8::StaticOrder S; S.init(MTOK, 2 * DFF, G, (int)blockIdx.x);
          pg8::EpiSwiGLU E{HID, DFF, ssqA}; pg8::gemm_phase<pg8::EpiSwiGLU, pg8::StaticOrder>(ldsl, g, S, E); }
        GSYNC();
        { pg8::Gemm g{HID, W2A, MTOK, DM, DFF, DFF, DFF}; pg8::StaticOrder S; S.init(MTOK, DM, G, (int)blockIdx.x);
          pg8::EpiResid<true> E{X, H, ssqB, DM, 0.5f, XB8}; pg8::gemm_phase<pg8::EpiResid<true>, pg8::StaticOrder>(ldsl, g, S, E); }
        GSYNC();
        { pg8::Gemm g{H, WIN, MTOK, NIN, DM, DM, DM}; pg8::StaticOrder S; S.init(MTOK, NIN, G, (int)blockIdx.x);
          pg8::EpiBf16<0> E{Z, NIN, nullptr, ssqB, 1.0f}; pg8::gemm_phase<pg8::EpiBf16<0>, pg8::StaticOrder>(ldsl, g, S, E); }
        { pg8::Gemm g{(const bf16_t*)XB8, (const bf16_t*)WG8, MTOK, NG, DM / 2, DM / 2, DM / 2}; pg8::StaticOrder S; S.init(MTOK, NG, G, (int)blockIdx.x);
          pg8::EpiBf16<2> E{GATES, NG, p.in[11] + (size_t)layer * NG, ssqB, 1.0f / WG8_SCALE}; pg8::gemm_phase<pg8::EpiBf16<2>, pg8::StaticOrder, true, true>(ldsl, g, S, E); }
        GSYNC();
        {
            const float* qg = p.in[7] + layer * 128; const float* kg = p.in[8] + layer * 128;
            const int a = lane >> 5, i = lane & 31, e1 = a * 64 + i, e2 = e1 + 32;
            const float invf = exp2f(-(float)(2 * i) * (1.0f / 64.0f) * 13.287712379549449f) * 0.15915494309189535f;
            const float gq1 = qg[e1], gq2 = qg[e2], gk1 = kg[e1], gk2 = kg[e2];
            for (int tok = gw; tok < MTOK; tok += NGW) {
                const int t = tok < 8192 ? (tok & 2047) : ((tok - 8192) & 4095);
                const int pa = a == 0 ? (t >> 6) : (t & 63);
                const float rev = __builtin_amdgcn_fractf((float)pa * invf);
                const float sn = __builtin_amdgcn_sinf(rev), cs = __builtin_amdgcn_cosf(rev);
                bf16_t* zp = Z + (size_t)tok * NIN + 1024;
                float x1[8], x2[8];
#pragma unroll
                for (int hh = 0; hh < 8; ++hh) { x1[hh] = bf2f(zp[hh * 128 + e1]); x2[hh] = bf2f(zp[hh * 128 + e2]); }
#pragma unroll
                for (int hh = 0; hh < 8; ++hh) {
                    const float ss = wave_sum(x1[hh] * x1[hh] + x2[hh] * x2[hh]);
                    const float rs = __builtin_amdgcn_rsqf(ss * (1.0f / 128.0f) + NORM_EPS);
                    const float y1 = x1[hh] * rs * (hh < 6 ? gq1 : gk1), y2 = x2[hh] * rs * (hh < 6 ? gq2 : gk2);
                    const float o1 = y1 * cs - y2 * sn, o2 = y2 * cs + y1 * sn;
                    zp[hh * 128 + e1] = (bf16_t)(cvt_pk_bf16(o1, 0.f) & 0xffffu); zp[hh * 128 + e2] = (bf16_t)(cvt_pk_bf16(o2, 0.f) & 0xffffu);
                }
            }
        }
        GSYNC();
        {
            unsigned* ctr = ctl + layer * 64;
            volatile int* qword = (volatile int*)(lds + att::OFF_Q);
            float* tabs = (float*)(lds + att::OFF_TAB);
            const float* relb = p.in[19];
            const int r32 = lane & 31, hi = lane >> 5;
            for (;;) {
                __syncthreads();
                if (tid == 0) *qword = (int)__hip_atomic_fetch_add(ctr, 1u, __ATOMIC_RELAXED, __HIP_MEMORY_SCOPE_AGENT);
                __syncthreads();
                const int u = *qword;
                if (u >= 1024) break;
                att::AttnP P;
                P.sink = 0.f; P.has_sink = 0; P.omode = 0; P.qpos = 0; P.hw = 0; P.tab = tabs; P.Cp = nullptr; P.cs = 0; P.Lp = nullptr; P.ls = 0; P.Yp = nullptr; P.ys = 0;
                if (u < 384) {
                    int tokbase, L, h, qb;
                    if (u < 192) { const int b = u / 96, rem = u % 96; h = rem / 16; qb = rem % 16; tokbase = 8192 + b * 4096; L = 4096; }
                    else { const int v = u - 192; const int b = v / 48, rem = v % 48; h = rem / 8; qb = rem % 8; tokbase = b * 2048; L = 2048; }
                    const int kvh = h / 3; const int row0 = tokbase + qb * 256 + wave * 32;
                    P.Qw = Z + (size_t)(row0 + r32) * NIN + 1024 + h * 128 + hi * 8;
                    P.Kb = Z + (size_t)tokbase * NIN + 1792 + kvh * 128; P.Vb = Z + (size_t)tokbase * NIN + 2048 + kvh * 128; P.ks = NIN;
                    P.k0 = 0; P.NT = L / 64; P.L = L;
                    P.Yp = Y + (size_t)row0 * NY + 512 + h * 128; P.ys = NY;
                    att::attn_body<0>(P, (char*)lds);
                } else {
                    const int g = wave >> 2, wq = wave & 3;
                    if (u < 640) {
                        const int v = u - 384; int tokbase, L, blk, kvh;
                        if (v < 128) { const int b = v / 32, rem = v % 32; blk = rem >> 1; kvh = rem & 1; tokbase = b * 2048; L = 2048; }
                        else { const int v2 = v - 128; const int b = v2 / 64, rem = v2 % 64; blk = rem >> 1; kvh = rem & 1; tokbase = 8192 + b * 4096; L = 4096; }
                        const int head = kvh * 2 + g; const int pos0 = blk * 128 + wq * 32;
                        for (int e = tid; e < 2 * 257; e += 512) { const int gg = e / 257, idx = e - gg * 257; tabs[gg * att::TAB_STRIDE + idx] = relb[t5_bucket(idx - 128) * 10 + kvh * 2 + gg] * att::INV_SCALE; }
                        P.Qw = Z + (size_t)(tokbase + pos0 + r32) * NIN + head * 128 + hi * 8;
                        P.Kb = Z + (size_t)tokbase * NIN + 512 + kvh * 128; P.Vb = Z + (size_t)tokbase * NIN + 768 + kvh * 128; P.ks = NIN;
                        P.k0 = blk * 128 - 128; P.NT = 6; P.L = L; P.qpos = pos0 + r32; P.hw = 128; P.tab = tabs + g * att::TAB_STRIDE;
                        P.sink = p.in[9][layer * 4 + head]; P.has_sink = 1; P.omode = 0;
                        P.Yp = Y + (size_t)(tokbase + pos0) * NY + head * 128; P.ys = NY;
                    } else {
                        const int w = u - 640; const int i = w >> 7, v = w & 127; const int r = i == 0 ? 1 : (i == 1 ? 4 : 16);
                        int tokbase, L, ww;
                        if (v < 64) { const int b = v >> 4; ww = v & 15; tokbase = b * 2048; L = 2048; }
                        else { const int b = (v - 64) >> 5; ww = (v - 64) & 31; tokbase = 8192 + b * 4096; L = 4096; }
                        const int Ls = L / r, nblk = Ls >> 7; const int c = ww / nblk, blk = ww - c * nblk;
                        const int qhead = i * 2 + g; const int pos0 = blk * 128 + wq * 32;
                        for (int e = tid; e < 2 * 129; e += 512) { const int gg = e / 129, idx = e - gg * 129; tabs[gg * att::TAB_STRIDE + idx] = relb[t5_bucket((idx - 64) * r) * 10 + 4 + i * 2 + gg] * att::INV_SCALE; }
                        const size_t tok0 = (size_t)tokbase + c;
                        P.Qw = Z + (tok0 + (size_t)(pos0 + r32) * r) * NIN + 2304 + qhead * 128 + hi * 8;
                        P.Kb = Z + tok0 * NIN + 3072 + i * 128; P.Vb = Z + tok0 * NIN + 3456 + i * 128; P.ks = (long)r * NIN;
                        P.k0 = blk * 128 - 64; P.NT = 4; P.L = Ls; P.qpos = pos0 + r32; P.hw = 64; P.tab = tabs + g * att::TAB_STRIDE;
                        P.omode = 1;
                        const size_t orow0 = (size_t)i * MTOK + tok0 + (size_t)pos0 * r;
                        P.Cp = CO + orow0 * 256 + g * 128; P.cs = (long)r * 256; P.Lp = CLSE + orow0 * 2 + g; P.ls = (long)r * 2;
                    }
                    __syncthreads();
                    att::attn_banded(P, (char*)lds);
                }
            }
        }
        GSYNC();
        {
            for (int it0 = gw; it0 < MTOK * 2; it0 += 4 * NGW) {
                f32x2 ca[4], cb[4], cc[4]; float l0[4], l1[4], l2[4];
#pragma unroll
                for (int q = 0; q < 4; ++q) { const int it = it0 + q * NGW, tok = it >> 1, g = it & 1;
                    l0[q] = CLSE[((size_t)0 * MTOK + tok) * 2 + g]; l1[q] = CLSE[((size_t)1 * MTOK + tok) * 2 + g]; l2[q] = CLSE[((size_t)2 * MTOK + tok) * 2 + g];
                    ca[q] = *(const f32x2*)(CO + ((size_t)0 * MTOK + tok) * 256 + g * 128 + lane * 2);
                    cb[q] = *(const f32x2*)(CO + ((size_t)1 * MTOK + tok) * 256 + g * 128 + lane * 2);
                    cc[q] = *(const f32x2*)(CO + ((size_t)2 * MTOK + tok) * 256 + g * 128 + lane * 2); }
#pragma unroll
                for (int q = 0; q < 4; ++q) { const int it = it0 + q * NGW, tok = it >> 1, g = it & 1;
                    const float mx = fmaxf(l0[q], fmaxf(l1[q], l2[q]));
                    float w0 = __expf(l0[q] - mx), w1 = __expf(l1[q] - mx), w2 = __expf(l2[q] - mx); const float inv = 1.0f / (w0 + w1 + w2); w0 *= inv; w1 *= inv; w2 *= inv;
                    *(unsigned*)(Y + (size_t)tok * NY + 1280 + g * 128 + lane * 2) = cvt_pk_bf16(w0 * ca[q].x + w1 * cb[q].x + w2 * cc[q].x, w0 * ca[q].y + w1 * cb[q].y + w2 * cc[q].y); }
            }
        }
        GSYNC();
        { pg8::StaticOrder S; S.init(MTOK, DM, G, (int)blockIdx.x);
          { pg8::Gemm g{Y, WBR, MTOK, DM, 512, NY, NY}; pg8::EpiGateMul<true> E{GATES, NG, MRG, DM}; pg8::gemm_phase<pg8::EpiGateMul<true>, pg8::StaticOrder>(ldsl, g, S, E); }
          { pg8::Gemm g{Y + 512, WBR + 512, MTOK, DM, 768, NY, NY}; pg8::EpiGateMul<false> E{GATES + DM, NG, MRG, DM}; pg8::gemm_phase<pg8::EpiGateMul<false>, pg8::StaticOrder>(ldsl, g, S, E); }
          { pg8::Gemm g{Y + 1280, WBR + 1280, MTOK, DM, 256, NY, NY}; pg8::EpiGateMul<false> E{GATES + 2 * DM, NG, MRG, DM}; pg8::gemm_phase<pg8::EpiGateMul<false>, pg8::StaticOrder>(ldsl, g, S, E); }
        }
        GSYNC();
        { pg8::Gemm g{MRG, WO, MTOK, DM, DM, DM, DM}; pg8::StaticOrder S; S.init(MTOK, DM, G, (int)blockIdx.x);
          pg8::EpiResid<false> E{X, H, ssqC, DM, 1.0f, nullptr}; pg8::gemm_phase<pg8::EpiResid<false>, pg8::StaticOrder>(ldsl, g, S, E); }
        GSYNC();
        { pg8::Gemm g{H, W13B, MTOK, 2 * DFF, DM, DM, DM}; pg8::StaticOrder S; S.init(MTOK, 2 * DFF, G, (int)blockIdx.x);
          pg8::EpiSwiGLU E{HID, DFF, ssqC}; pg8::gemm_phase<pg8::EpiSwiGLU, pg8::StaticOrder>(ldsl, g, S, E); }
        GSYNC();
        { pg8::Gemm g{HID, W2B, MTOK, DM, DFF, DFF, DFF}; pg8::StaticOrder S; S.init(MTOK, DM, G, (int)blockIdx.x);
          pg8::EpiResid<false, layer + 1 < DEPTH> E{X, H, ssqN, DM, 0.5f, nullptr}; pg8::gemm_phase<pg8::EpiResid<false, layer + 1 < DEPTH>, pg8::StaticOrder>(ldsl, g, S, E); }
        GSYNC();
    }
}

__global__ void __launch_bounds__(512, 2) fwd_megakernel(Params p) {
    extern __shared__ __attribute__((aligned(16))) unsigned char lds[];
    constexpr size_t WS_BAR = 768 * 1024;
    if (blockIdx.x == 0) {
        if (threadIdx.x < 64) __hip_atomic_store((unsigned*)(p.ws + WS_CTL) + threadIdx.x * 64, 0u, __ATOMIC_RELAXED, __HIP_MEMORY_SCOPE_AGENT);
        for (int i = threadIdx.x; i < XCD_BAR_WORDS; i += 512) __hip_atomic_store((unsigned*)(p.ws + WS_BAR) + i, 0u, __ATOMIC_RELAXED, __HIP_MEMORY_SCOPE_AGENT);
    }
    { float* sq = (float*)(p.ws + 65536) + MTOK;
      for (int i = blockIdx.x * 512 + threadIdx.x; i < 6 * MTOK; i += gridDim.x * 512) sq[i] = 0.f; }
    volatile LAS unsigned* bst = (volatile LAS unsigned*)((LAS unsigned char*)lds + RING_BYTES + 1024);
    if (threadIdx.x < 2) bst[threadIdx.x] = 0u;
    asm volatile("s_waitcnt vmcnt(0) lgkmcnt(0)" ::: "memory");
    cg::this_grid().sync();
    const XcdBarrier xbar = xcd_barrier_post((unsigned*)(p.ws + WS_BAR), bst);
    run_layer<0>(p, lds, xbar);
    run_layer<1>(p, lds, xbar);
    const int lane = threadIdx.x & 63, gw = blockIdx.x * 8 + (threadIdx.x >> 6), NGW = gridDim.x * 8;
    for (int m = gw; m < MTOK; m += NGW) rms_row_f32(p.out + (size_t)m * DM, p.in[20], lane);
}

extern "C" void kernel_launch(void* const* d_in, const int* in_sizes, int n_in, void* d_out, int out_size, void* d_ws, size_t ws_size, hipStream_t stream) {
    static int grid = 0;
    if (grid == 0) {
        if (n_in != 21 || out_size != MTOK * DM || ws_size < WS_END) { fprintf(stderr, "kernel_launch: unexpected shapes (n_in %d out %d ws %zu)\n", n_in, out_size, ws_size); grid = -1; return; }
        int dev = 0, cus = 0, per_cu = 0;
        hipGetDevice(&dev); hipDeviceGetAttribute(&cus, hipDeviceAttributeMultiprocessorCount, dev);
        if (hipFuncSetAttribute((const void*)fwd_megakernel, hipFuncAttributeMaxDynamicSharedMemorySize, LDS_BYTES) != hipSuccess) { fprintf(stderr, "kernel_launch: hipFuncSetAttribute failed\n"); grid = -1; return; }
        if (hipOccupancyMaxActiveBlocksPerMultiprocessor(&per_cu, (const void*)fwd_megakernel, 512, LDS_BYTES) != hipSuccess || per_cu < 1) { fprintf(stderr, "kernel_launch: occupancy query failed (%d)\n", per_cu); per_cu = 1; }
        (void)hipGetLastError();
        grid = cus * 1;
    }
    if (grid < 0) return;
    Params p{};
    for (int i = 0; i < 21; ++i) p.in[i] = (const float*)d_in[i];
    p.out = (float*)d_out; p.ws = (unsigned char*)d_ws;
    void* args[] = {&p};
    hipError_t e = hipLaunchCooperativeKernel((const void*)fwd_megakernel, dim3(grid), dim3(512), args, LDS_BYTES, stream);
    if (e != hipSuccess) fprintf(stderr, "cooperative launch failed: %s (grid %d)\n", hipGetErrorString(e), grid);
}
```

```cpp
#include <hip/hip_runtime.h>
#include <hip/hip_cooperative_groups.h>
#include <cstdio>
#include <cstdint>
namespace cg = cooperative_groups;

#define LAS __attribute__((address_space(3)))
typedef unsigned short bf16_t;
typedef short bf16x8 __attribute__((ext_vector_type(8)));
typedef short s16x4 __attribute__((ext_vector_type(4)));
typedef float f32x4 __attribute__((ext_vector_type(4)));
typedef float f32x2 __attribute__((ext_vector_type(2)));
typedef float f32x16 __attribute__((ext_vector_type(16)));
typedef unsigned u32x4 __attribute__((ext_vector_type(4)));
typedef unsigned u32x2 __attribute__((ext_vector_type(2)));
typedef int v8i __attribute__((ext_vector_type(8)));
typedef int v4i __attribute__((ext_vector_type(4)));
typedef float v8f __attribute__((ext_vector_type(8)));

constexpr int DM = 2048, MTOK = 16384, DFF = 5632, NIN = 3840, NG = 6144, NY = 1536, DEPTH = 2;
constexpr float NORM_EPS = 1e-6f;
constexpr float LOG2E = 1.4426950408889634f;

typedef __bf16 bf16x2_t __attribute__((ext_vector_type(2)));
__device__ __forceinline__ unsigned cvt_pk_bf16(float lo, float hi) { f32x2 v = {lo, hi}; bf16x2_t b = __builtin_convertvector(v, bf16x2_t); return __builtin_bit_cast(unsigned, b); }
__device__ __forceinline__ float bf_lo(unsigned w) { return __uint_as_float(w << 16); }
__device__ __forceinline__ float bf_hi(unsigned w) { return __uint_as_float(w & 0xffff0000u); }
__device__ __forceinline__ float bf2f(bf16_t v) { return __uint_as_float(((unsigned)v) << 16); }
__device__ __forceinline__ float fast_sigmoid(float v) { return __builtin_amdgcn_rcpf(1.0f + __builtin_amdgcn_exp2f(-v * LOG2E)); }
__device__ __forceinline__ u32x2 cvt8_fp8(float a0, float a1, float a2, float a3, float a4, float a5, float a6, float a7);
#define LDS_WAIT() asm volatile("s_waitcnt lgkmcnt(0)" ::: "memory")

namespace pg8 {
constexpr int BM = 256, BK = 64, HALF = 128, HTB = HALF * BK * 2, STAGE_BYTES = 8 * HTB, NXCD = 8, WGM = 4;
__host__ __device__ __forceinline__ int lds_byte(int r, int c) { const int st = (r >> 4) * 2 + (c >> 5), rr = r & 15, cc = c & 31, ob = rr * 64 + cc * 2; return st * 1024 + (ob ^ (((ob >> 9) & 1) << 5)); }
__host__ __device__ __forceinline__ void stage_rc(int b, int& R, int& C) { const int st = b / 1024, sb = b % 1024, swz = sb ^ (((sb >> 9) & 1) << 5); R = (st >> 1) * 16 + swz / 64; C = (st & 1) * 32 + (swz % 64) / 2; }
__host__ __device__ __forceinline__ int perm32(int rho) { const int n = rho >> 4, i = rho & 15; return 8 * (i >> 2) + 4 * n + (i & 3); }

struct Unit { int pm, pn; int kofs = 0, nt = 0, seg = 2; };
struct Gemm { const bf16_t* A; const bf16_t* Bt; int M, N, K, lda, ldb; };

struct StaticOrder {
    int nM, nN, nwg, G, c;
    __device__ void init(int M, int N, int G_, int c_) { nM = M / BM; nN = N / BM; nwg = nM * nN; G = G_; c = c_; }
    __device__ bool next(int i, Unit& u) const {
        const long L = (long)i * G + c; if (L >= nwg) return false;
        int wgid = (int)L; { const int q = nwg / NXCD, r = nwg % NXCD, xcd = wgid % NXCD, off = wgid / NXCD; wgid = (xcd < r ? xcd * (q + 1) : r * (q + 1) + (xcd - r) * q) + off; }
        const int nig = WGM * nN, gid = wgid / nig, fm = gid * WGM, gsz = (nM - fm) < WGM ? (nM - fm) : WGM;
        u.pm = fm + ((wgid % nig) % gsz); u.pn = (wgid % nig) / gsz; return true;
    }
};

template <int ACT  > struct EpiBf16 {
    static constexpr bool PERM = true;
    bf16_t* O; int ldc; const float* bias; const float* ssq; float oscale;
    __device__ __forceinline__ void operator()(const f32x4 (&acc)[2][2][4][2], const Unit& u, int wr, int wc, int fr, int fq) const {
        const int row0 = u.pm * BM + wr * 64 + fr; const int col0 = u.pn * BM + wc * 32 + 8 * fq;
        float rs[2][4];
#pragma unroll
        for (int ai = 0; ai < 2; ++ai)
#pragma unroll
            for (int m = 0; m < 4; ++m) rs[ai][m] = oscale * __builtin_amdgcn_rsqf(ssq[row0 + ai * HALF + m * 16] * (1.0f / DM) + NORM_EPS);
        f32x4 bv[2][2];
#pragma unroll
        for (int bj = 0; bj < 2; ++bj)
#pragma unroll
            for (int n = 0; n < 2; ++n) bv[bj][n] = bias ? *(const f32x4*)(bias + col0 + bj * HALF + 4 * n) : (f32x4){0.f, 0.f, 0.f, 0.f};
#pragma unroll
        for (int ai = 0; ai < 2; ++ai)
#pragma unroll
            for (int m = 0; m < 4; ++m) { bf16_t* rowp = O + (size_t)(row0 + ai * HALF + m * 16) * ldc + col0;
#pragma unroll
                for (int bj = 0; bj < 2; ++bj) { f32x4 v0 = acc[ai][bj][m][0] * rs[ai][m] + bv[bj][0], v1 = acc[ai][bj][m][1] * rs[ai][m] + bv[bj][1];
                    if (ACT == 2) {
#pragma unroll
                        for (int j = 0; j < 4; ++j) { v0[j] = fast_sigmoid(v0[j]); v1[j] = fast_sigmoid(v1[j]); } }
                    u32x4 w; w.x = cvt_pk_bf16(v0[0], v0[1]); w.y = cvt_pk_bf16(v0[2], v0[3]); w.z = cvt_pk_bf16(v1[0], v1[1]); w.w = cvt_pk_bf16(v1[2], v1[3]);
                    *(u32x4*)(rowp + bj * HALF) = w; } }
    }
};
struct EpiSwiGLU {
    static constexpr bool PERM = true;
    bf16_t* O; int ldc; const float* ssq;
    __device__ __forceinline__ void operator()(const f32x4 (&acc)[2][2][4][2], const Unit& u, int wr, int wc, int fr, int fq) const {
        const int row0 = u.pm * BM + wr * 64 + fr; const int col0 = u.pn * HALF + wc * 32 + 8 * fq;
#pragma unroll
        for (int ai = 0; ai < 2; ++ai)
#pragma unroll
            for (int m = 0; m < 4; ++m) { bf16_t* rowp = O + (size_t)(row0 + ai * HALF + m * 16) * ldc + col0;
                const float rs = __builtin_amdgcn_rsqf(ssq[row0 + ai * HALF + m * 16] * (1.0f / DM) + NORM_EPS);
                f32x4 g0 = acc[ai][0][m][0] * rs, g1 = acc[ai][0][m][1] * rs; const f32x4 u0 = acc[ai][1][m][0] * rs, u1 = acc[ai][1][m][1] * rs;
#pragma unroll
                for (int j = 0; j < 4; ++j) { g0[j] = g0[j] * fast_sigmoid(g0[j]) * u0[j]; g1[j] = g1[j] * fast_sigmoid(g1[j]) * u1[j]; }
                u32x4 w; w.x = cvt_pk_bf16(g0[0], g0[1]); w.y = cvt_pk_bf16(g0[2], g0[3]); w.z = cvt_pk_bf16(g1[0], g1[1]); w.w = cvt_pk_bf16(g1[2], g1[3]);
                *(u32x4*)rowp = w; }
    }
};
template <bool FP8X, bool NEXT = true> struct EpiResid {
    static constexpr bool PERM = true;
    float* X; bf16_t* XB; float* ssq; int ldc; float scale; unsigned char* X8;
    __device__ __forceinline__ void operator()(const f32x4 (&acc)[2][2][4][2], const Unit& u, int wr, int wc, int fr, int fq) const {
        const int row0 = u.pm * BM + wr * 64 + fr; const int col0 = u.pn * BM + wc * 32 + 8 * fq;
#pragma unroll
        for (int ai = 0; ai < 2; ++ai) {
            f32x4 pre[4][2][2];
#pragma unroll
            for (int m = 0; m < 4; ++m) { const float* rowp = X + (size_t)(row0 + ai * HALF + m * 16) * ldc + col0;
#pragma unroll
                for (int bj = 0; bj < 2; ++bj) { pre[m][bj][0] = *(const f32x4*)(rowp + bj * HALF); pre[m][bj][1] = *(const f32x4*)(rowp + bj * HALF + 4); } }
            asm volatile("" ::: "memory");
#pragma unroll
            for (int m = 0; m < 4; ++m) { const int row = row0 + ai * HALF + m * 16; float* rowp = X + (size_t)row * ldc + col0; bf16_t* rowb = XB + (size_t)row * ldc + col0; float part = 0.f;
#pragma unroll
                for (int bj = 0; bj < 2; ++bj) { float* p = rowp + bj * HALF;
                    const f32x4 a = pre[m][bj][0] + acc[ai][bj][m][0] * scale, b = pre[m][bj][1] + acc[ai][bj][m][1] * scale; *(f32x4*)p = a; *(f32x4*)(p + 4) = b;
                    part += (a[0] * a[0] + a[1] * a[1]) + (a[2] * a[2] + a[3] * a[3]) + (b[0] * b[0] + b[1] * b[1]) + (b[2] * b[2] + b[3] * b[3]);
                    if (NEXT) { u32x4 w; w.x = cvt_pk_bf16(a[0], a[1]); w.y = cvt_pk_bf16(a[2], a[3]); w.z = cvt_pk_bf16(b[0], b[1]); w.w = cvt_pk_bf16(b[2], b[3]);
                    *(u32x4*)(rowb + bj * HALF) = w; }
                    if (FP8X) *(u32x2*)(X8 + (size_t)row * ldc + col0 + bj * HALF) = cvt8_fp8(a[0], a[1], a[2], a[3], b[0], b[1], b[2], b[3]); }
                if (NEXT) { part += __shfl_xor(part, 16); part += __shfl_xor(part, 32);
                if (fq == 0) __hip_atomic_fetch_add(ssq + row, part, __ATOMIC_RELAXED, __HIP_MEMORY_SCOPE_AGENT); } }
            asm volatile("" ::: "memory");
        }
    }
};
template <bool FIRST> struct EpiGateMul {
    static constexpr bool PERM = true;
    const bf16_t* Gt; int ldg; bf16_t* O; int ldc;
    __device__ __forceinline__ void operator()(const f32x4 (&acc)[2][2][4][2], const Unit& u, int wr, int wc, int fr, int fq) const {
        const int row0 = u.pm * BM + wr * 64 + fr; const int col0 = u.pn * BM + wc * 32 + 8 * fq;
#pragma unroll
        for (int ai = 0; ai < 2; ++ai) {
            u32x4 gv[4][2], mv[4][2];
#pragma unroll
            for (int m = 0; m < 4; ++m) { const size_t row = (size_t)(row0 + ai * HALF + m * 16);
#pragma unroll
                for (int bj = 0; bj < 2; ++bj) { gv[m][bj] = *(const u32x4*)(Gt + row * ldg + col0 + bj * HALF); if (!FIRST) mv[m][bj] = *(const u32x4*)(O + row * ldc + col0 + bj * HALF); } }
            asm volatile("" ::: "memory");
#pragma unroll
            for (int m = 0; m < 4; ++m) { const size_t row = (size_t)(row0 + ai * HALF + m * 16);
#pragma unroll
                for (int bj = 0; bj < 2; ++bj) { bf16_t* op = O + row * ldc + col0 + bj * HALF; const u32x4 g = gv[m][bj];
                    f32x4 v0 = acc[ai][bj][m][0], v1 = acc[ai][bj][m][1];
                    v0[0] *= bf_lo(g.x); v0[1] *= bf_hi(g.x); v0[2] *= bf_lo(g.y); v0[3] *= bf_hi(g.y);
                    v1[0] *= bf_lo(g.z); v1[1] *= bf_hi(g.z); v1[2] *= bf_lo(g.w); v1[3] *= bf_hi(g.w);
                    if (!FIRST) { const u32x4 mm = mv[m][bj];
                        v0[0] += bf_lo(mm.x); v0[1] += bf_hi(mm.x); v0[2] += bf_lo(mm.y); v0[3] += bf_hi(mm.y);
                        v1[0] += bf_lo(mm.z); v1[1] += bf_hi(mm.z); v1[2] += bf_lo(mm.w); v1[3] += bf_hi(mm.w); }
                    u32x4 w; w.x = cvt_pk_bf16(v0[0], v0[1]); w.y = cvt_pk_bf16(v0[2], v0[3]); w.z = cvt_pk_bf16(v1[0], v1[1]); w.w = cvt_pk_bf16(v1[2], v1[3]);
                    *(u32x4*)op = w; } }
            asm volatile("" ::: "memory");
        }
    }
};

struct MergeOrder {
    StaticOrder base;
    __device__ void init(int M, int N, int G_, int c_) { base.init(M, N, G_, c_); }
    __device__ bool next(int i, Unit& u) const {
        const int t = i / 3, sg = i - 3 * t; if (!base.next(t, u)) return false;
        u.seg = sg; u.kofs = sg == 0 ? 0 : (sg == 1 ? 512 : 1280); u.nt = sg == 0 ? 8 : (sg == 1 ? 12 : 4); return true;
    }
};
struct EpiMerge {
    static constexpr bool PERM = true;
    const bf16_t* Gt; int ldg; bf16_t* O; int ldc;
    __device__ __forceinline__ void operator()(f32x4 (&acc)[2][2][4][2], const Unit& u, int wr, int wc, int fr, int fq) const {
        const int row0 = u.pm * BM + wr * 64 + fr; const int col0 = u.pn * BM + wc * 32 + 8 * fq;
        const int c_num = u.seg * ldc, c_den = (u.seg + 1) * ldc;
#pragma unroll
        for (int ai = 0; ai < 2; ++ai) {
            u32x4 gn[4][2], gd[4][2];
#pragma unroll
            for (int m = 0; m < 4; ++m) { const size_t row = (size_t)(row0 + ai * HALF + m * 16);
#pragma unroll
                for (int bj = 0; bj < 2; ++bj) { gn[m][bj] = *(const u32x4*)(Gt + row * ldg + c_num + col0 + bj * HALF); gd[m][bj] = u.seg < 2 ? *(const u32x4*)(Gt + row * ldg + c_den + col0 + bj * HALF) : (u32x4){0u, 0u, 0u, 0u}; } }
            asm volatile("" ::: "memory");
#pragma unroll
            for (int m = 0; m < 4; ++m) { const size_t row = (size_t)(row0 + ai * HALF + m * 16);
#pragma unroll
                for (int bj = 0; bj < 2; ++bj) { const u32x4 a = gn[m][bj], d = gd[m][bj];
                    float f[8] = {bf_lo(a.x), bf_hi(a.x), bf_lo(a.y), bf_hi(a.y), bf_lo(a.z), bf_hi(a.z), bf_lo(a.w), bf_hi(a.w)};
                    const float dd[8] = {bf_lo(d.x), bf_hi(d.x), bf_lo(d.y), bf_hi(d.y), bf_lo(d.z), bf_hi(d.z), bf_lo(d.w), bf_hi(d.w)};
#pragma unroll
                    for (int j = 0; j < 8; ++j) { if (u.seg > 0) f[j] = fmaxf(f[j], 1e-4f); if (u.seg < 2) f[j] = f[j] * __builtin_amdgcn_rcpf(fmaxf(dd[j], 1e-4f)); }
                    f32x4 v0 = acc[ai][bj][m][0], v1 = acc[ai][bj][m][1];
                    v0[0] *= f[0]; v0[1] *= f[1]; v0[2] *= f[2]; v0[3] *= f[3]; v1[0] *= f[4]; v1[1] *= f[5]; v1[2] *= f[6]; v1[3] *= f[7];
                    acc[ai][bj][m][0] = v0; acc[ai][bj][m][1] = v1;
                    if (u.seg == 2) { u32x4 w; w.x = cvt_pk_bf16(v0[0], v0[1]); w.y = cvt_pk_bf16(v0[2], v0[3]); w.z = cvt_pk_bf16(v1[0], v1[1]); w.w = cvt_pk_bf16(v1[2], v1[3]);
                        *(u32x4*)(O + row * ldc + col0 + bj * HALF) = w; } } }
            asm volatile("" ::: "memory");
        }
    }
};

template <class Epi, class Sched, bool ALIGN_EPI = true, bool FP8 = false>
__device__ __forceinline__ void gemm_phase(LAS unsigned char* lds, const Gemm g, const Sched& S, const Epi& E) {
    int tid_ = threadIdx.x; asm volatile("" : "+v"(tid_));
    const int tid = tid_, wid = __builtin_amdgcn_readfirstlane(tid >> 6), lane = tid & 63, wr = wid >> 2, wc = wid & 3, fr = lane & 15, fq = lane >> 4;
    const int nt = g.K / BK;
    unsigned voffA[2], voffB[2];
#pragma unroll
    for (int i = 0; i < 2; ++i) { int R, C; stage_rc(tid * 16 + i * 8192, R, C); const int Rb = Epi::PERM ? ((R & ~31) + perm32(R & 31)) : R;
        voffA[i] = (unsigned)(R * g.lda + C) * 2u; voffB[i] = (unsigned)(Rb * g.ldb + C) * 2u; }
    const size_t kstep = (size_t)(BK * 2);
    const size_t hstepA = (size_t)HALF * g.lda * 2, hstepB = (size_t)HALF * g.ldb * 2;
    const size_t tstepA = 2 * hstepA, tstepB = 2 * hstepB;
    const unsigned ldsw = (unsigned)wid * 1024u;
    const int aoff = lds_byte(wr * 64 + fr, fq * 8), boff = lds_byte(wc * 32 + fr, fq * 8);
#define PG8_SA(b, h) (((b) * 2 + (h)) * HTB)
#define PG8_SB(b, h) ((4 + (b) * 2 + (h)) * HTB)
#define PG8_STAGE(bufoff, gbase, voff) do { _Pragma("unroll") for (int _i = 0; _i < 2; ++_i) \
        __builtin_amdgcn_global_load_lds((const unsigned*)((const char*)(gbase) + (voff)[_i]), (LAS unsigned*)(lds + (bufoff) + ldsw + _i * 8192), 16, 0, 0); } while (0)
#define PG8_LDA(dst, b, h) do { _Pragma("unroll") for (int m = 0; m < 4; ++m) { \
        if constexpr (FP8) { dst##8[m].lo = *(const LAS v4i*)(lds + PG8_SA(b, h) + aoff + m * 2048); dst##8[m].hi = *(const LAS v4i*)(lds + PG8_SA(b, h) + aoff + m * 2048 + 1024); } \
        else { _Pragma("unroll") for (int k = 0; k < 2; ++k) dst[m][k] = *(const LAS bf16x8*)(lds + PG8_SA(b, h) + aoff + m * 2048 + k * 1024); } } } while (0)
#define PG8_LDB(dst, b, h) do { _Pragma("unroll") for (int n = 0; n < 2; ++n) { \
        if constexpr (FP8) { dst##8[n].lo = *(const LAS v4i*)(lds + PG8_SB(b, h) + boff + n * 2048); dst##8[n].hi = *(const LAS v4i*)(lds + PG8_SB(b, h) + boff + n * 2048 + 1024); } \
        else { _Pragma("unroll") for (int k = 0; k < 2; ++k) dst[n][k] = *(const LAS bf16x8*)(lds + PG8_SB(b, h) + boff + n * 2048 + k * 1024); } } } while (0)
#define PG8_MMA(ai, bj, At, Bt) do { __builtin_amdgcn_s_setprio(1); _Pragma("unroll") for (int m = 0; m < 4; ++m) _Pragma("unroll") for (int n = 0; n < 2; ++n) { \
        if constexpr (FP8) asm volatile("v_mfma_scale_f32_16x16x128_f8f6f4 %0, %1, %2, %0, %3, %3 op_sel_hi:[0,0,0]" : "+v"(acc[ai][bj][m][n]) : "v"(Bt##8[n]), "v"(At##8[m]), "v"(sc7f)); \
        else { _Pragma("unroll") for (int k = 0; k < 2; ++k) acc[ai][bj][m][n] = __builtin_amdgcn_mfma_f32_16x16x32_bf16(Bt[n][k], At[m][k], acc[ai][bj][m][n], 0, 0, 0); } } \
        __builtin_amdgcn_s_setprio(0); } while (0)
#define PG8_WAIT_V(n) asm volatile("s_waitcnt vmcnt(" #n ")" ::: "memory")
#define PG8_WAIT_L(n) asm volatile("s_waitcnt lgkmcnt(" #n ")" ::: "memory")
#define PG8_BAR __builtin_amdgcn_s_barrier()
#define PG8_SCHED __builtin_amdgcn_sched_barrier(0)
    Unit cur, nxt; int ui = 0;
    if (!S.next(0, cur)) return;
    f32x4 acc[2][2][4][2];
#pragma unroll
    for (int a = 0; a < 2; ++a)
#pragma unroll
        for (int b = 0; b < 2; ++b)
#pragma unroll
            for (int m = 0; m < 4; ++m)
#pragma unroll
                for (int n = 0; n < 2; ++n) acc[a][b][m][n] = (f32x4){0.f, 0.f, 0.f, 0.f};
    const int sc7f = 0x7F7F7F7F;
    bf16x8 At[4][2], B0[2][2], B1[2][2];
    v8i At8[4], B08[2], B18[2];
    const char* cA = (const char*)g.A + (size_t)cur.pm * tstepA + (size_t)cur.kofs * 2; const char* cB = (const char*)g.Bt + (size_t)cur.pn * tstepB + (size_t)cur.kofs * 2;
    PG8_STAGE(PG8_SB(0, 0), cB, voffB); PG8_STAGE(PG8_SB(0, 1), cB + hstepB, voffB); PG8_STAGE(PG8_SA(0, 0), cA, voffA); PG8_STAGE(PG8_SA(0, 1), cA + hstepA, voffA);
    if (wr == 1) PG8_BAR;
    PG8_WAIT_V(2); PG8_BAR;
    PG8_STAGE(PG8_SB(1, 0), cB + kstep, voffB); PG8_STAGE(PG8_SA(1, 0), cA + kstep, voffA); PG8_STAGE(PG8_SB(1, 1), cB + hstepB + kstep, voffB);
    PG8_WAIT_V(6); PG8_BAR;
    for (;;) {
        const bool has_next = S.next(ui + 1, nxt);
        const char* nA = has_next ? (const char*)g.A + (size_t)nxt.pm * tstepA + (size_t)nxt.kofs * 2 : cA; const char* nB = has_next ? (const char*)g.Bt + (size_t)nxt.pn * tstepB + (size_t)nxt.kofs * 2 : cB;
        const int ntc = cur.nt ? cur.nt : nt;
        for (int t = 0; t < ntc; t += 2) {
            const bool last = (t == ntc - 2);
            const char* a1 = cA + (size_t)(t + 1) * kstep;
            const char* a2 = last ? nA : cA + (size_t)(t + 2) * kstep; const char* b2 = last ? nB : cB + (size_t)(t + 2) * kstep;
            const char* a3 = a2 + kstep; const char* b3 = b2 + kstep;
            PG8_LDB(B0, 0, 0); PG8_LDB(B1, 0, 1); PG8_SCHED; PG8_LDA(At, 0, 0); PG8_STAGE(PG8_SA(1, 1), a1 + hstepA, voffA);
            PG8_WAIT_V(8); PG8_WAIT_L(0); PG8_BAR; PG8_MMA(0, 0, At, B0); PG8_MMA(0, 1, At, B1); PG8_BAR; PG8_SCHED;
            PG8_LDA(At, 0, 1); PG8_STAGE(PG8_SB(0, 0), b2, voffB); PG8_STAGE(PG8_SB(0, 1), b2 + hstepB, voffB); PG8_STAGE(PG8_SA(0, 0), a2, voffA);
            PG8_WAIT_V(8); PG8_WAIT_L(0); PG8_BAR; PG8_MMA(1, 0, At, B0); PG8_MMA(1, 1, At, B1); PG8_BAR; PG8_SCHED;
            PG8_LDB(B0, 1, 0); PG8_LDB(B1, 1, 1); PG8_SCHED; PG8_LDA(At, 1, 0); PG8_STAGE(PG8_SA(0, 1), a2 + hstepA, voffA);
            PG8_WAIT_V(8); PG8_WAIT_L(0); PG8_BAR; PG8_MMA(0, 0, At, B0); PG8_MMA(0, 1, At, B1); PG8_BAR; PG8_SCHED;
            PG8_LDA(At, 1, 1); PG8_STAGE(PG8_SB(1, 0), b3, voffB); PG8_STAGE(PG8_SB(1, 1), b3 + hstepB, voffB); PG8_STAGE(PG8_SA(1, 0), a3, voffA);
            PG8_WAIT_V(8); PG8_WAIT_L(0); PG8_BAR; PG8_MMA(1, 0, At, B0); PG8_MMA(1, 1, At, B1); PG8_BAR; PG8_SCHED;
        }
        if constexpr (ALIGN_EPI) { if (wr == 0) PG8_BAR; }
        if constexpr (FP8) asm volatile("s_nop 15\n\ts_nop 15" ::: "memory");
        E(acc, cur, wr, wc, fr, fq);
        if (!has_next) break;
        if (cur.seg == 2) {
#pragma unroll
        for (int a = 0; a < 2; ++a)
#pragma unroll
            for (int b = 0; b < 2; ++b)
#pragma unroll
                for (int m = 0; m < 4; ++m)
#pragma unroll
                    for (int n = 0; n < 2; ++n) acc[a][b][m][n] = (f32x4){0.f, 0.f, 0.f, 0.f};
        }
        cur = nxt; cA = nA; cB = nB; ++ui;
        if constexpr (ALIGN_EPI) { if (wr == 1) PG8_BAR; }
    }
    PG8_WAIT_V(0);
    if constexpr (!ALIGN_EPI) { if (wr == 0) PG8_BAR; }
    PG8_BAR;
#undef PG8_SA
#undef PG8_SB
#undef PG8_STAGE
#undef PG8_LDA
#undef PG8_LDB
#undef PG8_MMA
#undef PG8_WAIT_V
#undef PG8_WAIT_L
#undef PG8_BAR
#undef PG8_SCHED
}
}

namespace att {
constexpr int NW = 8, QBLK = 32, KVBLK = 64;
constexpr float SCALE = 0.088388347648318440f, INV_SCALE = 11.313708498984761f;
constexpr float THR = 8.f;
constexpr int SHM_V = KVBLK * 128 * 2, SHM_K = KVBLK * 128 * 2;
constexpr int OFF_WS = 2 * SHM_V + 2 * SHM_K, OFF_TAB = OFF_WS + NW * 64 * 4, TAB_STRIDE = 264, OFF_Q = OFF_TAB + 2 * TAB_STRIDE * 4, LDS_BYTES = OFF_Q + 16;
#define KSWZ(row, colB) ((row) * 256 + ((colB) ^ (((row) & 7) << 4)))
#define SBAR() __builtin_amdgcn_sched_barrier(0)
__device__ __forceinline__ int crow(int r, int hi) { return (r & 3) + 8 * (r >> 2) + 4 * hi; }

__device__ __forceinline__ void partialSM(f32x16& p0, f32x16& p1, float& m_reg, float& mn, float& alpha) {
  constexpr float C = SCALE * 1.4426950408889634f;
  float pmax = p0[0];
#pragma unroll
  for (int r = 1; r < 16; ++r) pmax = fmaxf(pmax, p0[r]);
#pragma unroll
  for (int r = 0; r < 16; ++r) pmax = fmaxf(pmax, p1[r]);
  { auto rr = __builtin_amdgcn_permlane32_swap(__float_as_uint(pmax), __float_as_uint(pmax), false, false);
    pmax = fmaxf(__uint_as_float(rr[0]), __uint_as_float(rr[1])); }
  if (__builtin_expect(__all(pmax - m_reg <= THR / SCALE), 1)) { mn = m_reg; alpha = 1.f; }
  else { mn = fmaxf(m_reg, pmax); alpha = __builtin_amdgcn_exp2f((m_reg - mn) * C); m_reg = mn; }
  float mnC = -mn * C;
#pragma unroll
  for (int r = 0; r < 16; ++r) p0[r] = fmaf(p0[r], C, mnC);
#pragma unroll
  for (int r = 0; r < 16; ++r) p1[r] = fmaf(p1[r], C, mnC);
#pragma unroll
  for (int r = 0; r < 16; ++r) p0[r] = __builtin_amdgcn_exp2f(p0[r]);
}
__device__ __forceinline__ void finishSM(f32x16& p0, f32x16& p1, float alpha, float& l_reg, bf16x8& pa0, bf16x8& pa1, bf16x8& pa2, bf16x8& pa3) {
#pragma unroll
  for (int r = 0; r < 16; ++r) p1[r] = __builtin_amdgcn_exp2f(p1[r]);
  float ps = 0;
#pragma unroll
  for (int r = 0; r < 16; ++r) ps += p0[r];
#pragma unroll
  for (int r = 0; r < 16; ++r) ps += p1[r];
  { auto rr = __builtin_amdgcn_permlane32_swap(__float_as_uint(ps), __float_as_uint(ps), false, false);
    ps = __uint_as_float(rr[0]) + __uint_as_float(rr[1]); }
  l_reg = l_reg * alpha + ps;
#define PK4(P, BASE, OUT) do { unsigned a0 = cvt_pk_bf16(P[BASE + 0], P[BASE + 1]), a1 = cvt_pk_bf16(P[BASE + 2], P[BASE + 3]);   \
    unsigned b0 = cvt_pk_bf16(P[BASE + 4], P[BASE + 5]), b1 = cvt_pk_bf16(P[BASE + 6], P[BASE + 7]);                              \
    auto r0 = __builtin_amdgcn_permlane32_swap(a0, b0, false, false); auto r1 = __builtin_amdgcn_permlane32_swap(a1, b1, false, false); \
    u32x4 w = {r0[0], r1[0], r0[1], r1[1]}; OUT = *reinterpret_cast<bf16x8*>(&w); } while (0)
  PK4(p0, 0, pa0); PK4(p0, 8, pa1); PK4(p1, 0, pa2); PK4(p1, 8, pa3);
#undef PK4
}
__device__ __forceinline__ void qkt(f32x16& p0, f32x16& p1, const bf16_t* Ks, const bf16x8* qr, int r32, int hi) {
  p0 = f32x16{}; p1 = f32x16{};
#pragma unroll
  for (int d0 = 0; d0 < 8; ++d0) { int cb = (d0 * 16 + hi * 8) * 2;
    bf16x8 b0 = *reinterpret_cast<const bf16x8*>((const char*)Ks + KSWZ(r32, cb));
    bf16x8 b1 = *reinterpret_cast<const bf16x8*>((const char*)Ks + KSWZ(32 + r32, cb));
    p0 = __builtin_amdgcn_mfma_f32_32x32x16_bf16(b0, qr[d0], p0, 0, 0, 0);
    p1 = __builtin_amdgcn_mfma_f32_32x32x16_bf16(b1, qr[d0], p1, 0, 0, 0); }
}
__device__ __forceinline__ void maskbias_half(f32x16& p, int kb, int qpos, int hw, int L, const float* tab, int hi) {
  float bv[16];
#pragma unroll
  for (int r = 0; r < 16; ++r) { const int ri = kb + crow(r, hi) - qpos + hw; bv[r] = tab[min(max(ri, 0), 2 * hw)]; }
#pragma unroll
  for (int r = 0; r < 16; ++r) asm volatile("" : "+v"(bv[r]));
#pragma unroll
  for (int r = 0; r < 16; ++r) { const int key = kb + crow(r, hi); const int ri = key - qpos + hw;
    const bool ok = ((unsigned)ri <= (unsigned)(2 * hw)) && ((unsigned)key < (unsigned)L);
    p[r] = ok ? p[r] + bv[r] : -1e30f; }
}
__device__ __forceinline__ void maskbias(f32x16& p0, f32x16& p1, int kbase, int qpos, int hw, int L, const float* tab, int hi) {
  maskbias_half(p0, kbase, qpos, hw, L, tab, hi); maskbias_half(p1, kbase + 32, qpos, hw, L, tab, hi);
}
__device__ __forceinline__ int v_st(int k, int c) { const int kk = (k & ~0xC) | ((k & 4) << 1) | ((k & 8) >> 1); return ((kk >> 3) * 4 + (c >> 5)) * 512 + ((kk & 7) * 32 + (c & 31)) * 2; }
__device__ __forceinline__ int v_rd_base(int lane) { return ((lane & 3) << 3) | (((lane >> 2) & 3) << 6) | (((lane >> 4) & 1) << 5) | (((lane >> 5) & 1) << 8); }
constexpr int v_rd_off(int d0, int ks, int half) { return d0 * 512 + ks * 4096 + half * 2048; }
template <int OFF> __device__ __forceinline__ s16x4 tr_read(int vb) {
  s16x4 r; asm volatile("ds_read_b64_tr_b16 %0, %1 offset:%2" : "=&v"(r) : "v"(vb), "i"(OFF) : "memory"); return r;
}
template <int D0> __device__ __forceinline__ void pv_one(f32x16& od, int vb, bf16x8 pa0, bf16x8 pa1, bf16x8 pa2, bf16x8 pa3) {
  const s16x4 l0 = tr_read<v_rd_off(D0, 0, 0)>(vb), h0 = tr_read<v_rd_off(D0, 0, 1)>(vb), l1 = tr_read<v_rd_off(D0, 1, 0)>(vb), h1 = tr_read<v_rd_off(D0, 1, 1)>(vb);
  const s16x4 l2 = tr_read<v_rd_off(D0, 2, 0)>(vb), h2 = tr_read<v_rd_off(D0, 2, 1)>(vb), l3 = tr_read<v_rd_off(D0, 3, 0)>(vb), h3 = tr_read<v_rd_off(D0, 3, 1)>(vb);
  asm volatile("s_waitcnt lgkmcnt(0)" ::: "memory"); SBAR();
#define PK(L, H) (bf16x8){L[0], L[1], L[2], L[3], H[0], H[1], H[2], H[3]}
  od = __builtin_amdgcn_mfma_f32_32x32x16_bf16(pa0, PK(l0, h0), od, 0, 0, 0);
  od = __builtin_amdgcn_mfma_f32_32x32x16_bf16(pa1, PK(l1, h1), od, 0, 0, 0);
  od = __builtin_amdgcn_mfma_f32_32x32x16_bf16(pa2, PK(l2, h2), od, 0, 0, 0);
  od = __builtin_amdgcn_mfma_f32_32x32x16_bf16(pa3, PK(l3, h3), od, 0, 0, 0);
#undef PK
}
__device__ __forceinline__ void pv_d0(f32x16* o, int vb, bf16x8 pa0, bf16x8 pa1, bf16x8 pa2, bf16x8 pa3) {
  pv_one<0>(o[0], vb, pa0, pa1, pa2, pa3); pv_one<1>(o[1], vb, pa0, pa1, pa2, pa3); pv_one<2>(o[2], vb, pa0, pa1, pa2, pa3); pv_one<3>(o[3], vb, pa0, pa1, pa2, pa3);
}

struct AttnP {
  const bf16_t* Qw;
  const bf16_t* Kb; const bf16_t* Vb;
  long ks;
  int k0, NT, L;
  int qpos, hw;
  const float* tab;
  float sink; int has_sink;
  int omode;
  bf16_t* Yp; long ys;
  float* Cp; long cs; float* Lp; long ls;
};

#ifndef ATT_SDEPTH
#define ATT_SDEPTH 1
#endif
template <int MODE>
__device__ __forceinline__ void attn_body(const AttnP& P, char* lds) {
  int tid_ = threadIdx.x; asm volatile("" : "+v"(tid_));
  const int tid = tid_, wid = tid >> 6, lane = tid & 63, r32 = lane & 31, hi = lane >> 5;
  bf16_t* V_lds = (bf16_t*)lds; bf16_t* K_lds = (bf16_t*)(lds + 2 * SHM_V);
  float* ws = (float*)(lds + OFF_WS) + wid * 64; float* li_l = ws; float* al_l = ws + 32;
  float m_reg = -1e4f, l_reg = 0; f32x16 o[4] = {}; bf16x8 qr[8];
#pragma unroll
  for (int d0 = 0; d0 < 8; ++d0) qr[d0] = *reinterpret_cast<const bf16x8*>(P.Qw + d0 * 16);
  const int sr = tid >> 4, sc = (tid & 15) * 8, vst0 = v_st(sr, sc), vst1 = v_st(32 + sr, sc);
  const int vb0 = (int)(uintptr_t)V_lds + v_rd_base(lane);
  constexpr int SDEPTH = ATT_SDEPTH;
  struct { bf16x8 vs0, vs1, ks0, ks1; } sr_[SDEPTH];
#define KROW(kp) (MODE ? min(max((kp), 0), P.L - 1) : (kp))
#define SLOAD(i, t_) do { const int kk0_ = P.k0 + (t_) * KVBLK; const long ra_ = (long)KROW(kk0_ + sr) * (MODE ? P.ks : (long)3840) + sc, rb_ = (long)KROW(kk0_ + 32 + sr) * (MODE ? P.ks : (long)3840) + sc; \
    sr_[i].vs0 = *reinterpret_cast<const bf16x8*>(P.Vb + ra_); sr_[i].vs1 = *reinterpret_cast<const bf16x8*>(P.Vb + rb_); \
    sr_[i].ks0 = *reinterpret_cast<const bf16x8*>(P.Kb + ra_); sr_[i].ks1 = *reinterpret_cast<const bf16x8*>(P.Kb + rb_); } while (0)
#define SWRITE(b, i) do { *(bf16x8*)((char*)V_lds + (b) * SHM_V + vst0) = sr_[i].vs0;          \
    *(bf16x8*)((char*)V_lds + (b) * SHM_V + vst1) = sr_[i].vs1; int kc = sc * 2;               \
    *(bf16x8*)((char*)K_lds + (b) * SHM_K + KSWZ(sr, kc)) = sr_[i].ks0;                       \
    *(bf16x8*)((char*)K_lds + (b) * SHM_K + KSWZ(32 + sr, kc)) = sr_[i].ks1; } while (0)
#define SWAIT() do { if constexpr (SDEPTH == 2) asm volatile("s_waitcnt vmcnt(4)" ::: "memory"); else asm volatile("s_waitcnt vmcnt(0)" ::: "memory"); } while (0)
#define RESC(a) do { if (__any((a) < 1.f)) { if (hi == 0) al_l[r32] = (a); asm volatile("s_waitcnt lgkmcnt(0)" ::: "memory"); \
    _Pragma("unroll") for (int d = 0; d < 4; ++d) _Pragma("unroll") for (int r = 0; r < 16; ++r) o[d][r] *= al_l[crow(r, hi)]; } } while (0)
#define MB(p0_, p1_, t_) do { if (MODE) maskbias(p0_, p1_, P.k0 + (t_) * KVBLK, P.qpos, P.hw, P.L, P.tab, hi); } while (0)
  f32x16 pA0, pA1, pB0, pB1; float mnA, mnB, alA, alB; bf16x8 pa0, pa1, pa2, pa3; const int NT = P.NT;
  constexpr int SE = 0, SO = SDEPTH - 1;
  SLOAD(SE, 0); asm volatile("s_waitcnt vmcnt(0)" ::: "memory"); SWRITE(0, SE); __syncthreads();
  qkt(pA0, pA1, K_lds, qr, r32, hi); MB(pA0, pA1, 0); partialSM(pA0, pA1, m_reg, mnA, alA);
  SLOAD(SO, 1); if constexpr (SDEPTH == 2) { if (2 < NT) SLOAD(SE, 2); }
  SWAIT(); SWRITE(1, SO); __syncthreads();
  for (int j = 1; j + 1 < NT; j += 2) {
    SBAR(); qkt(pB0, pB1, (bf16_t*)((char*)K_lds + SHM_K), qr, r32, hi); MB(pB0, pB1, j);
    finishSM(pA0, pA1, alA, l_reg, pa0, pa1, pa2, pa3); SBAR();
    SLOAD(SO, (j + SDEPTH < NT) ? j + SDEPTH : j); SBAR();
    pv_d0(o, vb0, pa0, pa1, pa2, pa3); partialSM(pB0, pB1, m_reg, mnB, alB);
    __syncthreads(); SWAIT(); SWRITE(0, SE);
    RESC(alB); __syncthreads();
    SBAR(); qkt(pA0, pA1, K_lds, qr, r32, hi); MB(pA0, pA1, j + 1);
    finishSM(pB0, pB1, alB, l_reg, pa0, pa1, pa2, pa3); SBAR();
    if (SDEPTH == 1 || j + 3 < NT) SLOAD(SE, j + 1 + SDEPTH); SBAR();
    pv_d0(o, vb0 + (int)SHM_V, pa0, pa1, pa2, pa3); partialSM(pA0, pA1, m_reg, mnA, alA);
    __syncthreads(); SWAIT(); SWRITE(1, SO);
    RESC(alA); __syncthreads();
  }
  SBAR(); qkt(pB0, pB1, (bf16_t*)((char*)K_lds + SHM_K), qr, r32, hi); MB(pB0, pB1, NT - 1);
  finishSM(pA0, pA1, alA, l_reg, pa0, pa1, pa2, pa3); SBAR();
  pv_d0(o, vb0, pa0, pa1, pa2, pa3); partialSM(pB0, pB1, m_reg, mnB, alB);
  __syncthreads(); RESC(alB);
  finishSM(pB0, pB1, alB, l_reg, pa0, pa1, pa2, pa3); SBAR();
  pv_d0(o, vb0 + (int)SHM_V, pa0, pa1, pa2, pa3);
  asm volatile("s_waitcnt vmcnt(0)" ::: "memory");
  if (MODE) { if (P.has_sink) l_reg += __builtin_amdgcn_exp2f((P.sink - m_reg * SCALE) * LOG2E); }
  if (hi == 0) li_l[r32] = l_reg; asm volatile("s_waitcnt lgkmcnt(0)" ::: "memory");
  float rli[16];
#pragma unroll
  for (int r = 0; r < 16; ++r) rli[r] = __builtin_amdgcn_rcpf(li_l[crow(r, hi)]);
  if (!MODE || P.omode == 0) {
#pragma unroll
    for (int r = 0; r < 16; ++r) { const int orow = crow(r, hi);
#pragma unroll
      for (int d0 = 0; d0 < 4; ++d0) P.Yp[(long)orow * (MODE ? P.ys : (long)1536) + d0 * 32 + r32] = (bf16_t)(cvt_pk_bf16(o[d0][r] * rli[r], 0.f) & 0xffffu); }
  } else {
#pragma unroll
    for (int r = 0; r < 16; ++r) { const int orow = crow(r, hi);
#pragma unroll
      for (int d0 = 0; d0 < 4; ++d0) P.Cp[(long)orow * P.cs + d0 * 32 + r32] = o[d0][r] * rli[r]; }
    if (hi == 0) P.Lp[(long)r32 * P.ls] = m_reg * SCALE + __logf(l_reg);
  }
#undef KROW
#undef SLOAD
#undef SWRITE
#undef SWAIT
#undef RESC
#undef MB
}

__device__ __forceinline__ void attn_banded(const AttnP& P, char* lds) {
  int tid_ = threadIdx.x; asm volatile("" : "+v"(tid_));
  const int tid = tid_, wid = tid >> 6, lane = tid & 63, r32 = lane & 31, hi = lane >> 5;
  bf16_t* V_lds = (bf16_t*)lds; bf16_t* K_lds = (bf16_t*)(lds + 2 * SHM_V);
  float* ws = (float*)(lds + OFF_WS) + wid * 64; float* li_l = ws; float* al_l = ws + 32;
  float m_reg = -1e4f, l_reg = 0; f32x16 o[4] = {}; bf16x8 qr[8];
#pragma unroll
  for (int d0 = 0; d0 < 8; ++d0) qr[d0] = *reinterpret_cast<const bf16x8*>(P.Qw + d0 * 16);
  const int sr = tid >> 4, sc = (tid & 15) * 8, vst0 = v_st(sr, sc), vst1 = v_st(32 + sr, sc);
  const int vb0 = (int)(uintptr_t)V_lds + v_rd_base(lane);
  bf16x8 vs0, vs1, ks0, ks1;
#define KROW(kp) min(max((kp), 0), P.L - 1)
#define SLOAD(t_) do { const int kk0_ = P.k0 + (t_) * KVBLK; const long ra_ = (long)KROW(kk0_ + sr) * P.ks + sc, rb_ = (long)KROW(kk0_ + 32 + sr) * P.ks + sc; \
    vs0 = *reinterpret_cast<const bf16x8*>(P.Vb + ra_); vs1 = *reinterpret_cast<const bf16x8*>(P.Vb + rb_); \
    ks0 = *reinterpret_cast<const bf16x8*>(P.Kb + ra_); ks1 = *reinterpret_cast<const bf16x8*>(P.Kb + rb_); } while (0)
#define SWRITE(b) do { *(bf16x8*)((char*)V_lds + (b) * SHM_V + vst0) = vs0; *(bf16x8*)((char*)V_lds + (b) * SHM_V + vst1) = vs1; const int kc = sc * 2; \
    *(bf16x8*)((char*)K_lds + (b) * SHM_K + KSWZ(sr, kc)) = ks0; *(bf16x8*)((char*)K_lds + (b) * SHM_K + KSWZ(32 + sr, kc)) = ks1; } while (0)
  SLOAD(0); asm volatile("s_waitcnt vmcnt(0)" ::: "memory"); SWRITE(0);
  const int NT = P.NT;
  for (int t = 0; t < NT; ++t) {
    const int b = t & 1;
    if (t + 1 < NT) SLOAD(t + 1);
    __syncthreads();
    f32x16 p0, p1; float mn, al; bf16x8 pa0, pa1, pa2, pa3;
    qkt(p0, p1, (bf16_t*)((char*)K_lds + b * SHM_K), qr, r32, hi);
    maskbias(p0, p1, P.k0 + t * KVBLK, P.qpos, P.hw, P.L, P.tab, hi);
    partialSM(p0, p1, m_reg, mn, al);
    if (__any(al < 1.f)) { if (hi == 0) al_l[r32] = al; asm volatile("s_waitcnt lgkmcnt(0)" ::: "memory");
#pragma unroll
      for (int d = 0; d < 4; ++d)
#pragma unroll
        for (int r = 0; r < 16; ++r) o[d][r] *= al_l[crow(r, hi)]; }
    finishSM(p0, p1, al, l_reg, pa0, pa1, pa2, pa3); SBAR();
    pv_d0(o, vb0 + b * (int)SHM_V, pa0, pa1, pa2, pa3);
    if (t + 1 < NT) { asm volatile("s_waitcnt vmcnt(0)" ::: "memory"); SWRITE(b ^ 1); }
  }
  if (P.has_sink) l_reg += __builtin_amdgcn_exp2f((P.sink - m_reg * SCALE) * LOG2E);
  if (hi == 0) li_l[r32] = l_reg; asm volatile("s_waitcnt lgkmcnt(0)" ::: "memory");
  float rli[16];
#pragma unroll
  for (int r = 0; r < 16; ++r) rli[r] = __builtin_amdgcn_rcpf(li_l[crow(r, hi)]);
  if (P.omode == 0) {
#pragma unroll
    for (int r = 0; r < 16; ++r) { const int orow = crow(r, hi);
#pragma unroll
      for (int d0 = 0; d0 < 4; ++d0) P.Yp[(long)orow * P.ys + d0 * 32 + r32] = (bf16_t)(cvt_pk_bf16(o[d0][r] * rli[r], 0.f) & 0xffffu); }
  } else {
#pragma unroll
    for (int r = 0; r < 16; ++r) { const int orow = crow(r, hi);
#pragma unroll
      for (int d0 = 0; d0 < 4; ++d0) P.Cp[(long)orow * P.cs + d0 * 32 + r32] = o[d0][r] * rli[r]; }
    if (hi == 0) P.Lp[(long)r32 * P.ls] = m_reg * SCALE + __logf(l_reg);
  }
#undef KROW
#undef SLOAD
#undef SWRITE
}
}

constexpr size_t MiB = 1u << 20;
constexpr size_t WS_CTL = 0, WS_W13A = 1 * MiB, WS_W2A = 45 * MiB, WS_WIN = 67 * MiB, WS_WG = 82 * MiB, WS_WBR = 106 * MiB, WS_WO = 112 * MiB,
                 WS_W13B = 120 * MiB, WS_W2B = 164 * MiB, WS_H = 186 * MiB, WS_R1 = 250 * MiB, WS_Z = WS_R1, WS_Y = 370 * MiB, WS_MRG = 418 * MiB,
                 WS_HID = WS_R1, WS_CO = WS_MRG, WS_CLSE = WS_MRG + 48 * MiB, WS_GATES = 482 * MiB, WS_XB8 = 674 * MiB, WS_WG8 = 706 * MiB, WS_END = 718 * MiB;
constexpr int RING_BYTES = 131072, LDS_BYTES = 147456;
static_assert(att::LDS_BYTES <= RING_BYTES, "attention LDS fits in the ring");

struct Params { const float* in[21]; float* out; unsigned char* ws; };

__device__ __forceinline__ float wave_sum(float v) {
#pragma unroll
    for (int o = 1; o < 64; o <<= 1) v += __shfl_xor(v, o);
    return v;
}

__device__ __forceinline__ void cvt_item(const float* __restrict__ W, int N, bf16_t* __restrict__ WT, int ldw, int koff, int mode, LAS float* scr, int item, int lane, const float* __restrict__ gain = nullptr) {
    const int nblk = N / 32, kb = item / nblk, nb = item - kb * nblk, k0 = 64 * kb, n0 = 32 * nb;
    const int lr = lane >> 3, lc = (lane & 7) * 4;
    f32x4 v[8];
#pragma unroll
    for (int i = 0; i < 8; ++i) v[i] = *(const f32x4*)(W + (size_t)(k0 + 8 * i + lr) * N + n0 + lc);
#pragma unroll
    for (int i = 0; i < 8; ++i) { const float gk = gain ? gain[k0 + 8 * i + lr] : 1.0f; LAS float* s = scr + (8 * i + lr) * 33 + lc; s[0] = v[i].x * gk; s[1] = v[i].y * gk; s[2] = v[i].z * gk; s[3] = v[i].w * gk; }
    LDS_WAIT();
    int drow0 = n0;
    if (mode == 1) { const int bj = n0 / DFF, rem = n0 - bj * DFF, pn = rem >> 7, c = rem & 127; drow0 = 256 * pn + 128 * bj + c; }
    const int c = lane & 7;
#pragma unroll
    for (int j = 0; j < 4; ++j) { const int n = (lane >> 3) + 8 * j; const LAS float* s = scr + (8 * c) * 33 + n;
        u32x4 o; o.x = cvt_pk_bf16(s[0 * 33], s[1 * 33]); o.y = cvt_pk_bf16(s[2 * 33], s[3 * 33]); o.z = cvt_pk_bf16(s[4 * 33], s[5 * 33]); o.w = cvt_pk_bf16(s[6 * 33], s[7 * 33]);
        *(u32x4*)(WT + (size_t)(drow0 + n) * ldw + koff + k0 + 8 * c) = o; }
    LDS_WAIT();
}


__device__ __forceinline__ u32x2 cvt8_fp8(float a0, float a1, float a2, float a3, float a4, float a5, float a6, float a7) {
    int w0 = __builtin_amdgcn_cvt_pk_fp8_f32(a0, a1, 0, false); w0 = __builtin_amdgcn_cvt_pk_fp8_f32(a2, a3, w0, true);
    int w1 = __builtin_amdgcn_cvt_pk_fp8_f32(a4, a5, 0, false); w1 = __builtin_amdgcn_cvt_pk_fp8_f32(a6, a7, w1, true);
    u32x2 r; r.x = (unsigned)w0; r.y = (unsigned)w1; return r;
}
constexpr float WG8_SCALE = 64.0f;
__device__ __forceinline__ void cvt_item_fp8(const float* __restrict__ W, int N, unsigned char* __restrict__ WT, int ldw, LAS float* scr, int item, int lane, const float* __restrict__ gain) {
    const int nblk = N / 32, kb = item / nblk, nb = item - kb * nblk, k0 = 64 * kb, n0 = 32 * nb;
    const int lr = lane >> 3, lc = (lane & 7) * 4;
    f32x4 v[8];
#pragma unroll
    for (int i = 0; i < 8; ++i) v[i] = *(const f32x4*)(W + (size_t)(k0 + 8 * i + lr) * N + n0 + lc);
#pragma unroll
    for (int i = 0; i < 8; ++i) { const float gk = gain[k0 + 8 * i + lr] * WG8_SCALE; LAS float* s = scr + (8 * i + lr) * 33 + lc; s[0] = v[i].x * gk; s[1] = v[i].y * gk; s[2] = v[i].z * gk; s[3] = v[i].w * gk; }
    LDS_WAIT();
    const int c = lane & 7;
#pragma unroll
    for (int j = 0; j < 4; ++j) { const int n = (lane >> 3) + 8 * j; const LAS float* s = scr + (8 * c) * 33 + n;
        *(u32x2*)(WT + (size_t)(n0 + n) * ldw + k0 + 8 * c) = cvt8_fp8(s[0 * 33], s[1 * 33], s[2 * 33], s[3 * 33], s[4 * 33], s[5 * 33], s[6 * 33], s[7 * 33]); }
    LDS_WAIT();
}

template <bool COPY>
__device__ __forceinline__ void rms_row_bf16(const float* __restrict__ xrow, const float* __restrict__ gain, bf16_t* __restrict__ orow, float* __restrict__ xcopy, int lane) {
    const f32x4* xr = (const f32x4*)xrow + lane;
    f32x4 v[8]; float s = 0.f;
#pragma unroll
    for (int j = 0; j < 8; ++j) { v[j] = xr[64 * j]; s += (v[j].x * v[j].x + v[j].y * v[j].y) + (v[j].z * v[j].z + v[j].w * v[j].w); }
    if (COPY) {
#pragma unroll
        for (int j = 0; j < 8; ++j) ((f32x4*)xcopy + lane)[64 * j] = v[j]; }
    const float rs = 1.0f / sqrtf(wave_sum(s) * (1.f / DM) + NORM_EPS);
    const f32x4* gr = (const f32x4*)gain + lane;
    u32x2* o8 = (u32x2*)orow + lane;
#pragma unroll
    for (int j = 0; j < 8; ++j) { const f32x4 g = gr[64 * j]; u32x2 w; w.x = cvt_pk_bf16(v[j].x * rs * g.x, v[j].y * rs * g.y); w.y = cvt_pk_bf16(v[j].z * rs * g.z, v[j].w * rs * g.w); o8[64 * j] = w; }
}
__device__ __forceinline__ void x_row_init(const float* __restrict__ xrow, float* __restrict__ xcopy, bf16_t* __restrict__ xb, float* __restrict__ ssq_row, int lane) {
    const f32x4* xr = (const f32x4*)xrow + lane;
    f32x4 v[8]; float s = 0.f;
#pragma unroll
    for (int j = 0; j < 8; ++j) { v[j] = xr[64 * j]; s += (v[j].x * v[j].x + v[j].y * v[j].y) + (v[j].z * v[j].z + v[j].w * v[j].w); }
#pragma unroll
    for (int j = 0; j < 8; ++j) ((f32x4*)xcopy + lane)[64 * j] = v[j];
    u32x2* o8 = (u32x2*)xb + lane;
#pragma unroll
    for (int j = 0; j < 8; ++j) { u32x2 w; w.x = cvt_pk_bf16(v[j].x, v[j].y); w.y = cvt_pk_bf16(v[j].z, v[j].w); o8[64 * j] = w; }
    s = wave_sum(s);
    if (lane == 0) *ssq_row = s;
}
__device__ __forceinline__ void rms_row_f32(float* __restrict__ xrow, const float* __restrict__ gain, int lane) {
    f32x4* xr = (f32x4*)xrow + lane;
    f32x4 v[8]; float s = 0.f;
#pragma unroll
    for (int j = 0; j < 8; ++j) { v[j] = xr[64 * j]; s += (v[j].x * v[j].x + v[j].y * v[j].y) + (v[j].z * v[j].z + v[j].w * v[j].w); }
    const float rs = 1.0f / sqrtf(wave_sum(s) * (1.f / DM) + NORM_EPS);
    const f32x4* gr = (const f32x4*)gain + lane;
#pragma unroll
    for (int j = 0; j < 8; ++j) { const f32x4 g = gr[64 * j]; f32x4 w; w.x = v[j].x * rs * g.x; w.y = v[j].y * rs * g.y; w.z = v[j].z * rs * g.z; w.w = v[j].w * rs * g.w; xr[64 * j] = w; }
}

__device__ __forceinline__ int t5_bucket(int rel) {
    const int n = rel < 0 ? -rel : rel;
    int b = n;
    if (n >= 8) { b = 5 + (31 - __clz(n)); b = b < 15 ? b : 15; }
    return (rel > 0 ? 16 : 0) + b;
}


#define XB_TMO      128
#define XB_XCNT(j)  (256  + 64 * (j))
#define XB_XSUB(j)  (1280 + 64 * (j))
#define XB_XGEN(j)  (2304 + 64 * (j))
#define XB_TOP      3328
#define XB_TOPGEN   3392
#define XCD_BAR_WORDS 3456
#define XB_SPIN_CAP (1u << 18)

__device__ __forceinline__ unsigned xb_ld(unsigned* p)              { return __hip_atomic_load(p, __ATOMIC_RELAXED, __HIP_MEMORY_SCOPE_AGENT); }
__device__ __forceinline__ unsigned xb_add(unsigned* p, unsigned v) { return __hip_atomic_fetch_add(p, v, __ATOMIC_RELAXED, __HIP_MEMORY_SCOPE_AGENT); }
__device__ __forceinline__ unsigned xb_xcc_id() { return (unsigned)__builtin_amdgcn_s_getreg((3 << 11) | 20) & 0xFu; }
#define XB_SPIN(cond, bar) do { unsigned _sp = 0; while (cond) { __builtin_amdgcn_s_sleep(1); \
    if ((++_sp & 255u) == 0u) { if (xb_ld(&(bar)[XB_TMO])) break; if (_sp > XB_SPIN_CAP) { atomicAdd(&(bar)[XB_TMO], 1u); break; } } } } while (0)

struct XcdBarrier {
    unsigned* bar; unsigned x;
    volatile LAS unsigned* st;
};

__device__ __forceinline__ XcdBarrier xcd_barrier_post(unsigned* bar, volatile LAS unsigned* st) {
    XcdBarrier b; b.bar = bar; b.x = xb_xcc_id(); b.st = st;
    if (threadIdx.x == 0) (void)xb_add(&bar[XB_XCNT(b.x)], 1u);
    return b;
}
__device__ __forceinline__ void xcd_barrier_complete(unsigned* bar, unsigned x, unsigned& nloc, unsigned& nx) {
    const unsigned G = gridDim.x * gridDim.y * gridDim.z;
    unsigned sum, cnt, mine, sp = 0u;
    for (;;) {
        sum = 0u; cnt = 0u; mine = 0u;
#pragma unroll
        for (unsigned j = 0; j < 16; ++j) { const unsigned c = xb_ld(&bar[XB_XCNT(j)]); sum += c; cnt += (c > 0u) ? 1u : 0u; mine = (j == x) ? c : mine; }
        if (sum == G) break;
        __builtin_amdgcn_s_sleep(1);
        if ((++sp & 255u) == 0u) { if (xb_ld(&bar[XB_TMO])) break; if (sp > XB_SPIN_CAP) { atomicAdd(&bar[XB_TMO], 1u); break; } }
    }
    nloc = mine > 0u ? mine : 1u; nx = cnt > 0u ? cnt : 1u;
}

__device__ __forceinline__ void xcd_barrier(const XcdBarrier& b) {
    asm volatile("s_waitcnt vmcnt(0)" ::: "memory");
    __syncthreads();
    if (threadIdx.x == 0) {
        unsigned* bar = b.bar;
        __builtin_amdgcn_s_waitcnt(0);
        unsigned nloc = b.st[0], nx = b.st[1];
        if (nloc == 0u) { xcd_barrier_complete(bar, b.x, nloc, nx); b.st[0] = nloc; b.st[1] = nx; }
        const unsigned old = xb_add(&bar[XB_XSUB(b.x)], 1u);
        const unsigned gen = old / nloc;
        if (old + 1u == (gen + 1u) * nloc) {
            __builtin_amdgcn_fence(__ATOMIC_RELEASE, "agent");
            asm volatile("s_waitcnt vmcnt(0)" ::: "memory");
            const unsigned og = xb_add(&bar[XB_TOP], 1u);
            const unsigned tg = og / nx;
            if (og + 1u == (tg + 1u) * nx) xb_add(&bar[XB_TOPGEN], 1u);
            else XB_SPIN(xb_ld(&bar[XB_TOPGEN]) == tg, bar);
            __builtin_amdgcn_fence(__ATOMIC_ACQUIRE, "agent");
            xb_add(&bar[XB_XGEN(b.x)], 1u);
            asm volatile("s_waitcnt vmcnt(0)" ::: "memory");
        } else {
            XB_SPIN(xb_ld(&bar[XB_XGEN(b.x)]) == gen, bar);
            __builtin_amdgcn_fence(__ATOMIC_ACQUIRE, "agent");
            asm volatile("s_waitcnt vmcnt(0)" ::: "memory");
        }
    }
    __syncthreads();
}


#define GSYNC() xcd_barrier(xbar)


template <int layer>
__device__ __forceinline__ void run_layer(const Params& p, unsigned char* lds, const XcdBarrier& xbar) {
    int tid_ = threadIdx.x; asm volatile("" : "+v"(tid_));
    const int tid = tid_, lane = tid & 63, wave = __builtin_amdgcn_readfirstlane(tid >> 6);
    const int G = gridDim.x, gw = blockIdx.x * 8 + wave, NGW = G * 8;
    unsigned char* ws = p.ws;
    unsigned* ctl = (unsigned*)(ws + WS_CTL);
    bf16_t* H = (bf16_t*)(ws + WS_H); bf16_t* Z = (bf16_t*)(ws + WS_Z); bf16_t* Y = (bf16_t*)(ws + WS_Y); bf16_t* MRG = (bf16_t*)(ws + WS_MRG);
    bf16_t* HID = (bf16_t*)(ws + WS_HID); bf16_t* GATES = (bf16_t*)(ws + WS_GATES); float* CO = (float*)(ws + WS_CO); float* CLSE = (float*)(ws + WS_CLSE);
    bf16_t* W13A = (bf16_t*)(ws + WS_W13A); bf16_t* W2A = (bf16_t*)(ws + WS_W2A); bf16_t* WIN = (bf16_t*)(ws + WS_WIN); unsigned char* WG8 = ws + WS_WG8; unsigned char* XB8 = ws + WS_XB8;
    bf16_t* WBR = (bf16_t*)(ws + WS_WBR); bf16_t* WO = (bf16_t*)(ws + WS_WO); bf16_t* W13B = (bf16_t*)(ws + WS_W13B); bf16_t* W2B = (bf16_t*)(ws + WS_W2B);
    float* X = p.out;
    LAS unsigned char* ldsl = (LAS unsigned char*)lds;
    float* SSQ = (float*)(ws + 65536);
    float* ssqA = SSQ + (size_t)(3 * layer) * MTOK; float* ssqB = ssqA + MTOK; float* ssqC = ssqB + MTOK; float* ssqN = ssqC + MTOK;
    {
        {
            LAS float* scr = (LAS float*)(ldsl + wave * 16384);
            const float* s_w13a = p.in[3] + (size_t)layer * DM * 2 * DFF; const float* s_w2a = p.in[4] + (size_t)layer * DFF * DM;
            const float* s_win = p.in[6] + (size_t)layer * DM * NIN; const float* s_wg = p.in[10] + (size_t)layer * DM * NG;
            const float* s_bra = p.in[12] + (size_t)layer * 512 * DM; const float* s_brb = p.in[13] + (size_t)layer * 768 * DM; const float* s_brc = p.in[14] + (size_t)layer * 256 * DM;
            const float* s_wo = p.in[15] + (size_t)layer * DM * DM;
            const float* s_w13b = p.in[17] + (size_t)layer * DM * 2 * DFF; const float* s_w2b = p.in[18] + (size_t)layer * DFF * DM;
            constexpr int I_13 = (DM / 64) * (2 * DFF / 32), I_2 = (DFF / 64) * (DM / 32), I_IN = (DM / 64) * (NIN / 32), I_G = (DM / 64) * (NG / 32),
                          I_BA = (512 / 64) * (DM / 32), I_BB = (768 / 64) * (DM / 32), I_BC = (256 / 64) * (DM / 32), I_O = (DM / 64) * (DM / 32);
            constexpr int NITEMS = 2 * I_13 + 2 * I_2 + I_IN + I_G + I_BA + I_BB + I_BC + I_O;
            for (int it = gw; it < NITEMS; it += NGW) {
                int r = it;
                if (r < I_13) { cvt_item(s_w13a, 2 * DFF, W13A, DM, 0, 1, scr, r, lane, p.in[2] + (size_t)layer * DM); continue; } r -= I_13;
                if (r < I_2) { cvt_item(s_w2a, DM, W2A, DFF, 0, 0, scr, r, lane); continue; } r -= I_2;
                if (r < I_IN) { cvt_item(s_win, NIN, WIN, DM, 0, 0, scr, r, lane, p.in[5] + (size_t)layer * DM); continue; } r -= I_IN;
                if (r < I_G) { cvt_item_fp8(s_wg, NG, WG8, DM, scr, r, lane, p.in[5] + (size_t)layer * DM); continue; } r -= I_G;
                if (r < I_BA) { cvt_item(s_bra, DM, WBR, NY, 0, 0, scr, r, lane); continue; } r -= I_BA;
                if (r < I_BB) { cvt_item(s_brb, DM, WBR, NY, 512, 0, scr, r, lane); continue; } r -= I_BB;
                if (r < I_BC) { cvt_item(s_brc, DM, WBR, NY, 1280, 0, scr, r, lane); continue; } r -= I_BC;
                if (r < I_O) { cvt_item(s_wo, DM, WO, DM, 0, 0, scr, r, lane); continue; } r -= I_O;
                if (r < I_13) { cvt_item(s_w13b, 2 * DFF, W13B, DM, 0, 1, scr, r, lane, p.in[16] + (size_t)layer * DM); continue; } r -= I_13;
                cvt_item(s_w2b, DM, W2B, DFF, 0, 0, scr, r, lane);
            }
            if (layer == 0) {
                for (int m = gw; m < MTOK; m += NGW) { const float* src = m < 8192 ? p.in[0] + (size_t)m * DM : p.in[1] + (size_t)(m - 8192) * DM;
                    x_row_init(src, X + (size_t)m * DM, H + (size_t)m * DM, ssqA + m, lane); }
            }
        }
        GSYNC();
        { pg8::Gemm g{H, W13A, MTOK, 2 * DFF, DM, DM, DM}; pg8::StaticOrder S; S.init(MTOK, 2 * DFF, G, (int)blockIdx.x);
          pg8::EpiSwiGLU E{HID, DFF, ssqA}; pg8::gemm_phase<pg8::EpiSwiGLU, pg8::StaticOrder>(ldsl, g, S, E); }
        GSYNC();
        { pg8::Gemm g{HID, W2A, MTOK, DM, DFF, DFF, DFF}; pg8::StaticOrder S; S.init(MTOK, DM, G, (int)blockIdx.x);
          pg8::EpiResid<true> E{X, H, ssqB, DM, 0.5f, XB8}; pg8::gemm_phase<pg8::EpiResid<true>, pg8::StaticOrder>(ldsl, g, S, E); }
        GSYNC();
        { pg8::Gemm g{H, WIN, MTOK, NIN, DM, DM, DM}; pg8::StaticOrder S; S.init(MTOK, NIN, G, (int)blockIdx.x);
          pg8::EpiBf16<0> E{Z, NIN, nullptr, ssqB, 1.0f}; pg8::gemm_phase<pg8::EpiBf16<0>, pg8::StaticOrder>(ldsl, g, S, E); }
        { pg8::Gemm g{(const bf16_t*)XB8, (const bf16_t*)WG8, MTOK, NG, DM / 2, DM / 2, DM / 2}; pg8::StaticOrder S; S.init(MTOK, NG, G, (int)blockIdx.x);
          pg8::EpiBf16<2> E{GATES, NG, p.in[11] + (size_t)layer * NG, ssqB, 1.0f / WG8_SCALE}; pg8::gemm_phase<pg8::EpiBf16<2>, pg8::StaticOrder, true, true>(ldsl, g, S, E); }
        GSYNC();
        {
            const float* qg = p.in[7] + layer * 128; const float* kg = p.in[8] + layer * 128;
            const int a = lane >> 5, i = lane & 31, e1 = a * 64 + i, e2 = e1 + 32;
            const float invf = exp2f(-(float)(2 * i) * (1.0f / 64.0f) * 13.287712379549449f) * 0.15915494309189535f;
            const float gq1 = qg[e1], gq2 = qg[e2], gk1 = kg[e1], gk2 = kg[e2];
            for (int tok = gw; tok < MTOK; tok += NGW) {
                const int t = tok < 8192 ? (tok & 2047) : ((tok - 8192) & 4095);
                const int pa = a == 0 ? (t >> 6) : (t & 63);
                const float rev = __builtin_amdgcn_fractf((float)pa * invf);
                const float sn = __builtin_amdgcn_sinf(rev), cs = __builtin_amdgcn_cosf(rev);
                bf16_t* zp = Z + (size_t)tok * NIN + 1024;
                float x1[8], x2[8];
#pragma unroll
                for (int hh = 0; hh < 8; ++hh) { x1[hh] = bf2f(zp[hh * 128 + e1]); x2[hh] = bf2f(zp[hh * 128 + e2]); }
#pragma unroll
                for (int hh = 0; hh < 8; ++hh) {
                    const float ss = wave_sum(x1[hh] * x1[hh] + x2[hh] * x2[hh]);
                    const float rs = __builtin_amdgcn_rsqf(ss * (1.0f / 128.0f) + NORM_EPS);
                    const float y1 = x1[hh] * rs * (hh < 6 ? gq1 : gk1), y2 = x2[hh] * rs * (hh < 6 ? gq2 : gk2);
                    const float o1 = y1 * cs - y2 * sn, o2 = y2 * cs + y1 * sn;
                    zp[hh * 128 + e1] = (bf16_t)(cvt_pk_bf16(o1, 0.f) & 0xffffu); zp[hh * 128 + e2] = (bf16_t)(cvt_pk_bf16(o2, 0.f) & 0xffffu);
                }
            }
        }
        GSYNC();
        {
            unsigned* ctr = ctl + layer * 64;
            volatile int* qword = (volatile int*)(lds + att::OFF_Q);
            float* tabs = (float*)(lds + att::OFF_TAB);
            const float* relb = p.in[19];
            const int r32 = lane & 31, hi = lane >> 5;
            for (;;) {
                __syncthreads();
                if (tid == 0) *qword = (int)__hip_atomic_fetch_add(ctr, 1u, __ATOMIC_RELAXED, __HIP_MEMORY_SCOPE_AGENT);
                __syncthreads();
                const int u = *qword;
                if (u >= 1024) break;
                att::AttnP P;
                P.sink = 0.f; P.has_sink = 0; P.omode = 0; P.qpos = 0; P.hw = 0; P.tab = tabs; P.Cp = nullptr; P.cs = 0; P.Lp = nullptr; P.ls = 0; P.Yp = nullptr; P.ys = 0;
                if (u < 384) {
                    int tokbase, L, h, qb;
                    if (u < 192) { const int b = u / 96, rem = u % 96; h = rem / 16; qb = rem % 16; tokbase = 8192 + b * 4096; L = 4096; }
                    else { const int v = u - 192; const int b = v / 48, rem = v % 48; h = rem / 8; qb = rem % 8; tokbase = b * 2048; L = 2048; }
                    const int kvh = h / 3; const int row0 = tokbase + qb * 256 + wave * 32;
                    P.Qw = Z + (size_t)(row0 + r32) * NIN + 1024 + h * 128 + hi * 8;
                    P.Kb = Z + (size_t)tokbase * NIN + 1792 + kvh * 128; P.Vb = Z + (size_t)tokbase * NIN + 2048 + kvh * 128; P.ks = NIN;
                    P.k0 = 0; P.NT = L / 64; P.L = L;
                    P.Yp = Y + (size_t)row0 * NY + 512 + h * 128; P.ys = NY;
                    att::attn_body<0>(P, (char*)lds);
                } else {
                    const int g = wave >> 2, wq = wave & 3;
                    if (u < 640) {
                        const int v = u - 384; int tokbase, L, blk, kvh;
                        if (v < 128) { const int b = v / 32, rem = v % 32; blk = rem >> 1; kvh = rem & 1; tokbase = b * 2048; L = 2048; }
                        else { const int v2 = v - 128; const int b = v2 / 64, rem = v2 % 64; blk = rem >> 1; kvh = rem & 1; tokbase = 8192 + b * 4096; L = 4096; }
                        const int head = kvh * 2 + g; const int pos0 = blk * 128 + wq * 32;
                        for (int e = tid; e < 2 * 257; e += 512) { const int gg = e / 257, idx = e - gg * 257; tabs[gg * att::TAB_STRIDE + idx] = relb[t5_bucket(idx - 128) * 10 + kvh * 2 + gg] * att::INV_SCALE; }
                        P.Qw = Z + (size_t)(tokbase + pos0 + r32) * NIN + head * 128 + hi * 8;
                        P.Kb = Z + (size_t)tokbase * NIN + 512 + kvh * 128; P.Vb = Z + (size_t)tokbase * NIN + 768 + kvh * 128; P.ks = NIN;
                        P.k0 = blk * 128 - 128; P.NT = 6; P.L = L; P.qpos = pos0 + r32; P.hw = 128; P.tab = tabs + g * att::TAB_STRIDE;
                        P.sink = p.in[9][layer * 4 + head]; P.has_sink = 1; P.omode = 0;
                        P.Yp = Y + (size_t)(tokbase + pos0) * NY + head * 128; P.ys = NY;
                    } else {
                        const int w = u - 640; const int i = w >> 7, v = w & 127; const int r = i == 0 ? 1 : (i == 1 ? 4 : 16);
                        int tokbase, L, ww;
                        if (v < 64) { const int b = v >> 4; ww = v & 15; tokbase = b * 2048; L = 2048; }
                        else { const int b = (v - 64) >> 5; ww = (v - 64) & 31; tokbase = 8192 + b * 4096; L = 4096; }
                        const int Ls = L / r, nblk = Ls >> 7; const int c = ww / nblk, blk = ww - c * nblk;
                        const int qhead = i * 2 + g; const int pos0 = blk * 128 + wq * 32;
                        for (int e = tid; e < 2 * 129; e += 512) { const int gg = e / 129, idx = e - gg * 129; tabs[gg * att::TAB_STRIDE + idx] = relb[t5_bucket((idx - 64) * r) * 10 + 4 + i * 2 + gg] * att::INV_SCALE; }
                        const size_t tok0 = (size_t)tokbase + c;
                        P.Qw = Z + (tok0 + (size_t)(pos0 + r32) * r) * NIN + 2304 + qhead * 128 + hi * 8;
                        P.Kb = Z + tok0 * NIN + 3072 + i * 128; P.Vb = Z + tok0 * NIN + 3456 + i * 128; P.ks = (long)r * NIN;
                        P.k0 = blk * 128 - 64; P.NT = 4; P.L = Ls; P.qpos = pos0 + r32; P.hw = 64; P.tab = tabs + g * att::TAB_STRIDE;
                        P.omode = 1;
                        const size_t orow0 = (size_t)i * MTOK + tok0 + (size_t)pos0 * r;
                        P.Cp = CO + orow0 * 256 + g * 128; P.cs = (long)r * 256; P.Lp = CLSE + orow0 * 2 + g; P.ls = (long)r * 2;
                    }
                    __syncthreads();
                    att::attn_banded(P, (char*)lds);
                }
            }
        }
        GSYNC();
        {
            for (int it0 = gw; it0 < MTOK * 2; it0 += 4 * NGW) {
                f32x2 ca[4], cb[4], cc[4]; float l0[4], l1[4], l2[4];
#pragma unroll
                for (int q = 0; q < 4; ++q) { const int it = it0 + q * NGW, tok = it >> 1, g = it & 1;
                    l0[q] = CLSE[((size_t)0 * MTOK + tok) * 2 + g]; l1[q] = CLSE[((size_t)1 * MTOK + tok) * 2 + g]; l2[q] = CLSE[((size_t)2 * MTOK + tok) * 2 + g];
                    ca[q] = *(const f32x2*)(CO + ((size_t)0 * MTOK + tok) * 256 + g * 128 + lane * 2);
                    cb[q] = *(const f32x2*)(CO + ((size_t)1 * MTOK + tok) * 256 + g * 128 + lane * 2);
                    cc[q] = *(const f32x2*)(CO + ((size_t)2 * MTOK + tok) * 256 + g * 128 + lane * 2); }
#pragma unroll
                for (int q = 0; q < 4; ++q) { const int it = it0 + q * NGW, tok = it >> 1, g = it & 1;
                    const float mx = fmaxf(l0[q], fmaxf(l1[q], l2[q]));
                    float w0 = __expf(l0[q] - mx), w1 = __expf(l1[q] - mx), w2 = __expf(l2[q] - mx); const float inv = 1.0f / (w0 + w1 + w2); w0 *= inv; w1 *= inv; w2 *= inv;
                    *(unsigned*)(Y + (size_t)tok * NY + 1280 + g * 128 + lane * 2) = cvt_pk_bf16(w0 * ca[q].x + w1 * cb[q].x + w2 * cc[q].x, w0 * ca[q].y + w1 * cb[q].y + w2 * cc[q].y); }
            }
        }
        GSYNC();
        { pg8::Gemm g{Y, WBR, MTOK, DM, NY, NY, NY}; pg8::MergeOrder S; S.init(MTOK, DM, G, (int)blockIdx.x);
          pg8::EpiMerge E{GATES, NG, MRG, DM}; pg8::gemm_phase<pg8::EpiMerge, pg8::MergeOrder>(ldsl, g, S, E); }
        GSYNC();
        { pg8::Gemm g{MRG, WO, MTOK, DM, DM, DM, DM}; pg8::StaticOrder S; S.init(MTOK, DM, G, (int)blockIdx.x);
          pg8::EpiResid<false> E{X, H, ssqC, DM, 1.0f, nullptr}; pg8::gemm_phase<pg8::EpiResid<false>, pg8::StaticOrder>(ldsl, g, S, E); }
        GSYNC();
        { pg8::Gemm g{H, W13B, MTOK, 2 * DFF, DM, DM, DM}; pg8::StaticOrder S; S.init(MTOK, 2 * DFF, G, (int)blockIdx.x);
          pg8::EpiSwiGLU E{HID, DFF, ssqC}; pg8::gemm_phase<pg8::EpiSwiGLU, pg8::StaticOrder>(ldsl, g, S, E); }
        GSYNC();
        { pg8::Gemm g{HID, W2B, MTOK, DM, DFF, DFF, DFF}; pg8::StaticOrder S; S.init(MTOK, DM, G, (int)blockIdx.x);
          pg8::EpiResid<false, layer + 1 < DEPTH> E{X, H, ssqN, DM, 0.5f, nullptr}; pg8::gemm_phase<pg8::EpiResid<false, layer + 1 < DEPTH>, pg8::StaticOrder>(ldsl, g, S, E); }
        GSYNC();
    }
}

__global__ void __launch_bounds__(512, 2) fwd_megakernel(Params p) {
    extern __shared__ __attribute__((aligned(16))) unsigned char lds[];
    constexpr size_t WS_BAR = 768 * 1024;
    if (blockIdx.x == 0) {
        if (threadIdx.x < 64) __hip_atomic_store((unsigned*)(p.ws + WS_CTL) + threadIdx.x * 64, 0u, __ATOMIC_RELAXED, __HIP_MEMORY_SCOPE_AGENT);
        for (int i = threadIdx.x; i < XCD_BAR_WORDS; i += 512) __hip_atomic_store((unsigned*)(p.ws + WS_BAR) + i, 0u, __ATOMIC_RELAXED, __HIP_MEMORY_SCOPE_AGENT);
    }
    { float* sq = (float*)(p.ws + 65536) + MTOK;
      for (int i = blockIdx.x * 512 + threadIdx.x; i < 6 * MTOK; i += gridDim.x * 512) sq[i] = 0.f; }
    volatile LAS unsigned* bst = (volatile LAS unsigned*)((LAS unsigned char*)lds + RING_BYTES + 1024);
    if (threadIdx.x < 2) bst[threadIdx.x] = 0u;
    asm volatile("s_waitcnt vmcnt(0) lgkmcnt(0)" ::: "memory");
    cg::this_grid().sync();
    const XcdBarrier xbar = xcd_barrier_post((unsigned*)(p.ws + WS_BAR), bst);
    run_layer<0>(p, lds, xbar);
    run_layer<1>(p, lds, xbar);
    const int lane = threadIdx.x & 63, gw = blockIdx.x * 8 + (threadIdx.x >> 6), NGW = gridDim.x * 8;
    for (int m = gw; m < MTOK; m += NGW) rms_row_f32(p.out + (size_t)m * DM, p.in[20], lane);
}

extern "C" void kernel_launch(void* const* d_in, const int* in_sizes, int n_in, void* d_out, int out_size, void* d_ws, size_t ws_size, hipStream_t stream) {
    static int grid = 0;
    if (grid == 0) {
        if (n_in != 21 || out_size != MTOK * DM || ws_size < WS_END) { fprintf(stderr, "kernel_launch: unexpected shapes (n_in %d out %d ws %zu)\n", n_in, out_size, ws_size); grid = -1; return; }
        int dev = 0, cus = 0, per_cu = 0;
        hipGetDevice(&dev); hipDeviceGetAttribute(&cus, hipDeviceAttributeMultiprocessorCount, dev);
        if (hipFuncSetAttribute((const void*)fwd_megakernel, hipFuncAttributeMaxDynamicSharedMemorySize, LDS_BYTES) != hipSuccess) { fprintf(stderr, "kernel_launch: hipFuncSetAttribute failed\n"); grid = -1; return; }
        if (hipOccupancyMaxActiveBlocksPerMultiprocessor(&per_cu, (const void*)fwd_megakernel, 512, LDS_BYTES) != hipSuccess || per_cu < 1) { fprintf(stderr, "kernel_launch: occupancy query failed (%d)\n", per_cu); per_cu = 1; }
        (void)hipGetLastError();
        grid = cus * 1;
    }
    if (grid < 0) return;
    Params p{};
    for (int i = 0; i < 21; ++i) p.in[i] = (const float*)d_in[i];
    p.out = (float*)d_out; p.ws = (unsigned char*)d_ws;
    void* args[] = {&p};
    hipError_t e = hipLaunchCooperativeKernel((const void*)fwd_megakernel, dim3(grid), dim3(512), args, LDS_BYTES, stream);
    if (e != hipSuccess) fprintf(stderr, "cooperative launch failed: %s (grid %d)\n", hipGetErrorString(e), grid);
}
```

```cpp
#include <hip/hip_runtime.h>
#include <hip/hip_cooperative_groups.h>
#include <cstdio>
#include <cstdint>
namespace cg = cooperative_groups;

#define LAS __attribute__((address_space(3)))
typedef unsigned short bf16_t;
typedef short bf16x8 __attribute__((ext_vector_type(8)));
typedef short s16x4 __attribute__((ext_vector_type(4)));
typedef float f32x4 __attribute__((ext_vector_type(4)));
typedef float f32x2 __attribute__((ext_vector_type(2)));
typedef float f32x16 __attribute__((ext_vector_type(16)));
typedef unsigned u32x4 __attribute__((ext_vector_type(4)));
typedef unsigned u32x2 __attribute__((ext_vector_type(2)));
typedef int v8i __attribute__((ext_vector_type(8)));
typedef int v4i __attribute__((ext_vector_type(4)));
typedef float v8f __attribute__((ext_vector_type(8)));

constexpr int DM = 2048, MTOK = 16384, DFF = 5632, NIN = 3840, NG = 6144, NY = 1536, DEPTH = 2;
constexpr float NORM_EPS = 1e-6f;
constexpr float LOG2E = 1.4426950408889634f;

typedef __bf16 bf16x2_t __attribute__((ext_vector_type(2)));
__device__ __forceinline__ unsigned cvt_pk_bf16(float lo, float hi) { f32x2 v = {lo, hi}; bf16x2_t b = __builtin_convertvector(v, bf16x2_t); return __builtin_bit_cast(unsigned, b); }
__device__ __forceinline__ float bf_lo(unsigned w) { return __uint_as_float(w << 16); }
__device__ __forceinline__ float bf_hi(unsigned w) { return __uint_as_float(w & 0xffff0000u); }
__device__ __forceinline__ float bf2f(bf16_t v) { return __uint_as_float(((unsigned)v) << 16); }
__device__ __forceinline__ float fast_sigmoid(float v) { return __builtin_amdgcn_rcpf(1.0f + __builtin_amdgcn_exp2f(-v * LOG2E)); }
__device__ __forceinline__ u32x2 cvt8_fp8(float a0, float a1, float a2, float a3, float a4, float a5, float a6, float a7);
constexpr float Y8_SCALE = 16.0f;
__device__ __forceinline__ unsigned char cvt1_fp8(float a) { return (unsigned char)(__builtin_amdgcn_cvt_pk_fp8_f32(a, a, 0, false) & 0xff); }
#define LDS_WAIT() asm volatile("s_waitcnt lgkmcnt(0)" ::: "memory")

namespace pg8 {
constexpr int BM = 256, BK = 64, HALF = 128, HTB = HALF * BK * 2, STAGE_BYTES = 8 * HTB, NXCD = 8, WGM = 4;
__host__ __device__ __forceinline__ int lds_byte(int r, int c) { const int st = (r >> 4) * 2 + (c >> 5), rr = r & 15, cc = c & 31, ob = rr * 64 + cc * 2; return st * 1024 + (ob ^ (((ob >> 9) & 1) << 5)); }
__host__ __device__ __forceinline__ void stage_rc(int b, int& R, int& C) { const int st = b / 1024, sb = b % 1024, swz = sb ^ (((sb >> 9) & 1) << 5); R = (st >> 1) * 16 + swz / 64; C = (st & 1) * 32 + (swz % 64) / 2; }
__host__ __device__ __forceinline__ int perm32(int rho) { const int n = rho >> 4, i = rho & 15; return 8 * (i >> 2) + 4 * n + (i & 3); }

struct Unit { int pm, pn; int kofs = 0, nt = 0, seg = 2; };
struct Gemm { const bf16_t* A; const bf16_t* Bt; int M, N, K, lda, ldb; };

struct StaticOrder {
    int nM, nN, nwg, G, c;
    __device__ void init(int M, int N, int G_, int c_) { nM = M / BM; nN = N / BM; nwg = nM * nN; G = G_; c = c_; }
    __device__ bool next(int i, Unit& u) const {
        const long L = (long)i * G + c; if (L >= nwg) return false;
        int wgid = (int)L; { const int q = nwg / NXCD, r = nwg % NXCD, xcd = wgid % NXCD, off = wgid / NXCD; wgid = (xcd < r ? xcd * (q + 1) : r * (q + 1) + (xcd - r) * q) + off; }
        const int nig = WGM * nN, gid = wgid / nig, fm = gid * WGM, gsz = (nM - fm) < WGM ? (nM - fm) : WGM;
        u.pm = fm + ((wgid % nig) % gsz); u.pn = (wgid % nig) / gsz; return true;
    }
};

template <int ACT  > struct EpiBf16 {
    static constexpr bool PERM = true;
    bf16_t* O; int ldc; const float* bias; const float* ssq; float oscale;
    __device__ __forceinline__ void operator()(const f32x4 (&acc)[2][2][4][2], const Unit& u, int wr, int wc, int fr, int fq) const {
        const int row0 = u.pm * BM + wr * 64 + fr; const int col0 = u.pn * BM + wc * 32 + 8 * fq;
        float rs[2][4];
#pragma unroll
        for (int ai = 0; ai < 2; ++ai)
#pragma unroll
            for (int m = 0; m < 4; ++m) rs[ai][m] = oscale * __builtin_amdgcn_rsqf(ssq[row0 + ai * HALF + m * 16] * (1.0f / DM) + NORM_EPS);
        f32x4 bv[2][2];
#pragma unroll
        for (int bj = 0; bj < 2; ++bj)
#pragma unroll
            for (int n = 0; n < 2; ++n) bv[bj][n] = bias ? *(const f32x4*)(bias + col0 + bj * HALF + 4 * n) : (f32x4){0.f, 0.f, 0.f, 0.f};
#pragma unroll
        for (int ai = 0; ai < 2; ++ai)
#pragma unroll
            for (int m = 0; m < 4; ++m) { bf16_t* rowp = O + (size_t)(row0 + ai * HALF + m * 16) * ldc + col0;
#pragma unroll
                for (int bj = 0; bj < 2; ++bj) { f32x4 v0 = acc[ai][bj][m][0] * rs[ai][m] + bv[bj][0], v1 = acc[ai][bj][m][1] * rs[ai][m] + bv[bj][1];
                    if (ACT == 2) {
#pragma unroll
                        for (int j = 0; j < 4; ++j) { v0[j] = fast_sigmoid(v0[j]); v1[j] = fast_sigmoid(v1[j]); } }
                    u32x4 w; w.x = cvt_pk_bf16(v0[0], v0[1]); w.y = cvt_pk_bf16(v0[2], v0[3]); w.z = cvt_pk_bf16(v1[0], v1[1]); w.w = cvt_pk_bf16(v1[2], v1[3]);
                    *(u32x4*)(rowp + bj * HALF) = w; } }
    }
};
struct EpiSwiGLU {
    static constexpr bool PERM = true;
    bf16_t* O; int ldc; const float* ssq;
    __device__ __forceinline__ void operator()(const f32x4 (&acc)[2][2][4][2], const Unit& u, int wr, int wc, int fr, int fq) const {
        const int row0 = u.pm * BM + wr * 64 + fr; const int col0 = u.pn * HALF + wc * 32 + 8 * fq;
#pragma unroll
        for (int ai = 0; ai < 2; ++ai)
#pragma unroll
            for (int m = 0; m < 4; ++m) { bf16_t* rowp = O + (size_t)(row0 + ai * HALF + m * 16) * ldc + col0;
                const float rs = __builtin_amdgcn_rsqf(ssq[row0 + ai * HALF + m * 16] * (1.0f / DM) + NORM_EPS);
                f32x4 g0 = acc[ai][0][m][0] * rs, g1 = acc[ai][0][m][1] * rs; const f32x4 u0 = acc[ai][1][m][0] * rs, u1 = acc[ai][1][m][1] * rs;
#pragma unroll
                for (int j = 0; j < 4; ++j) { g0[j] = g0[j] * fast_sigmoid(g0[j]) * u0[j]; g1[j] = g1[j] * fast_sigmoid(g1[j]) * u1[j]; }
                u32x4 w; w.x = cvt_pk_bf16(g0[0], g0[1]); w.y = cvt_pk_bf16(g0[2], g0[3]); w.z = cvt_pk_bf16(g1[0], g1[1]); w.w = cvt_pk_bf16(g1[2], g1[3]);
                *(u32x4*)rowp = w; }
    }
};
template <bool FP8X, bool NEXT = true> struct EpiResid {
    static constexpr bool PERM = true;
    float* X; bf16_t* XB; float* ssq; int ldc; float scale; unsigned char* X8;
    __device__ __forceinline__ void operator()(const f32x4 (&acc)[2][2][4][2], const Unit& u, int wr, int wc, int fr, int fq) const {
        const int row0 = u.pm * BM + wr * 64 + fr; const int col0 = u.pn * BM + wc * 32 + 8 * fq;
#pragma unroll
        for (int ai = 0; ai < 2; ++ai) {
            f32x4 pre[4][2][2];
#pragma unroll
            for (int m = 0; m < 4; ++m) { const float* rowp = X + (size_t)(row0 + ai * HALF + m * 16) * ldc + col0;
#pragma unroll
                for (int bj = 0; bj < 2; ++bj) { pre[m][bj][0] = *(const f32x4*)(rowp + bj * HALF); pre[m][bj][1] = *(const f32x4*)(rowp + bj * HALF + 4); } }
            asm volatile("" ::: "memory");
#pragma unroll
            for (int m = 0; m < 4; ++m) { const int row = row0 + ai * HALF + m * 16; float* rowp = X + (size_t)row * ldc + col0; bf16_t* rowb = XB + (size_t)row * ldc + col0; float part = 0.f;
#pragma unroll
                for (int bj = 0; bj < 2; ++bj) { float* p = rowp + bj * HALF;
                    const f32x4 a = pre[m][bj][0] + acc[ai][bj][m][0] * scale, b = pre[m][bj][1] + acc[ai][bj][m][1] * scale; *(f32x4*)p = a; *(f32x4*)(p + 4) = b;
                    part += (a[0] * a[0] + a[1] * a[1]) + (a[2] * a[2] + a[3] * a[3]) + (b[0] * b[0] + b[1] * b[1]) + (b[2] * b[2] + b[3] * b[3]);
                    if (NEXT) { u32x4 w; w.x = cvt_pk_bf16(a[0], a[1]); w.y = cvt_pk_bf16(a[2], a[3]); w.z = cvt_pk_bf16(b[0], b[1]); w.w = cvt_pk_bf16(b[2], b[3]);
                    *(u32x4*)(rowb + bj * HALF) = w; }
                    if (FP8X) *(u32x2*)(X8 + (size_t)row * ldc + col0 + bj * HALF) = cvt8_fp8(a[0], a[1], a[2], a[3], b[0], b[1], b[2], b[3]); }
                if (NEXT) { part += __shfl_xor(part, 16); part += __shfl_xor(part, 32);
                if (fq == 0) __hip_atomic_fetch_add(ssq + row, part, __ATOMIC_RELAXED, __HIP_MEMORY_SCOPE_AGENT); } }
            asm volatile("" ::: "memory");
        }
    }
};
template <bool FIRST> struct EpiGateMul {
    static constexpr bool PERM = true;
    const bf16_t* Gt; int ldg; bf16_t* O; int ldc;
    __device__ __forceinline__ void operator()(const f32x4 (&acc)[2][2][4][2], const Unit& u, int wr, int wc, int fr, int fq) const {
        const int row0 = u.pm * BM + wr * 64 + fr; const int col0 = u.pn * BM + wc * 32 + 8 * fq;
#pragma unroll
        for (int ai = 0; ai < 2; ++ai) {
            u32x4 gv[4][2], mv[4][2];
#pragma unroll
            for (int m = 0; m < 4; ++m) { const size_t row = (size_t)(row0 + ai * HALF + m * 16);
#pragma unroll
                for (int bj = 0; bj < 2; ++bj) { gv[m][bj] = *(const u32x4*)(Gt + row * ldg + col0 + bj * HALF); if (!FIRST) mv[m][bj] = *(const u32x4*)(O + row * ldc + col0 + bj * HALF); } }
            asm volatile("" ::: "memory");
#pragma unroll
            for (int m = 0; m < 4; ++m) { const size_t row = (size_t)(row0 + ai * HALF + m * 16);
#pragma unroll
                for (int bj = 0; bj < 2; ++bj) { bf16_t* op = O + row * ldc + col0 + bj * HALF; const u32x4 g = gv[m][bj];
                    f32x4 v0 = acc[ai][bj][m][0], v1 = acc[ai][bj][m][1];
                    v0[0] *= bf_lo(g.x); v0[1] *= bf_hi(g.x); v0[2] *= bf_lo(g.y); v0[3] *= bf_hi(g.y);
                    v1[0] *= bf_lo(g.z); v1[1] *= bf_hi(g.z); v1[2] *= bf_lo(g.w); v1[3] *= bf_hi(g.w);
                    if (!FIRST) { const u32x4 mm = mv[m][bj];
                        v0[0] += bf_lo(mm.x); v0[1] += bf_hi(mm.x); v0[2] += bf_lo(mm.y); v0[3] += bf_hi(mm.y);
                        v1[0] += bf_lo(mm.z); v1[1] += bf_hi(mm.z); v1[2] += bf_lo(mm.w); v1[3] += bf_hi(mm.w); }
                    u32x4 w; w.x = cvt_pk_bf16(v0[0], v0[1]); w.y = cvt_pk_bf16(v0[2], v0[3]); w.z = cvt_pk_bf16(v1[0], v1[1]); w.w = cvt_pk_bf16(v1[2], v1[3]);
                    *(u32x4*)op = w; } }
            asm volatile("" ::: "memory");
        }
    }
};

struct MergeOrder {
    StaticOrder base;
    __device__ void init(int M, int N, int G_, int c_) { base.init(M, N, G_, c_); }
    __device__ bool next(int i, Unit& u) const {
        const int t = i / 3, sg = i - 3 * t; if (!base.next(t, u)) return false;
        u.seg = sg; u.kofs = sg == 0 ? 0 : (sg == 1 ? 256 : 640); u.nt = sg == 0 ? 4 : (sg == 1 ? 6 : 2); return true;
    }
};
struct EpiMerge {
    static constexpr bool PERM = true;
    const bf16_t* Gt; int ldg; bf16_t* O; int ldc; float oscale;
    __device__ __forceinline__ void operator()(f32x4 (&acc)[2][2][4][2], const Unit& u, int wr, int wc, int fr, int fq) const {
        const int row0 = u.pm * BM + wr * 64 + fr; const int col0 = u.pn * BM + wc * 32 + 8 * fq;
        const int c_num = u.seg * ldc, c_den = (u.seg + 1) * ldc;
#pragma unroll
        for (int ai = 0; ai < 2; ++ai) {
            u32x4 gn[4][2], gd[4][2];
#pragma unroll
            for (int m = 0; m < 4; ++m) { const size_t row = (size_t)(row0 + ai * HALF + m * 16);
#pragma unroll
                for (int bj = 0; bj < 2; ++bj) { gn[m][bj] = *(const u32x4*)(Gt + row * ldg + c_num + col0 + bj * HALF); gd[m][bj] = u.seg < 2 ? *(const u32x4*)(Gt + row * ldg + c_den + col0 + bj * HALF) : (u32x4){0u, 0u, 0u, 0u}; } }
            asm volatile("" ::: "memory");
#pragma unroll
            for (int m = 0; m < 4; ++m) { const size_t row = (size_t)(row0 + ai * HALF + m * 16);
#pragma unroll
                for (int bj = 0; bj < 2; ++bj) { const u32x4 a = gn[m][bj], d = gd[m][bj];
                    float f[8] = {bf_lo(a.x), bf_hi(a.x), bf_lo(a.y), bf_hi(a.y), bf_lo(a.z), bf_hi(a.z), bf_lo(a.w), bf_hi(a.w)};
                    const float dd[8] = {bf_lo(d.x), bf_hi(d.x), bf_lo(d.y), bf_hi(d.y), bf_lo(d.z), bf_hi(d.z), bf_lo(d.w), bf_hi(d.w)};
#pragma unroll
                    for (int j = 0; j < 8; ++j) { if (u.seg > 0) f[j] = fmaxf(f[j], 1e-4f); if (u.seg < 2) f[j] = f[j] * __builtin_amdgcn_rcpf(fmaxf(dd[j], 1e-4f)); else f[j] *= oscale; }
                    f32x4 v0 = acc[ai][bj][m][0], v1 = acc[ai][bj][m][1];
                    v0[0] *= f[0]; v0[1] *= f[1]; v0[2] *= f[2]; v0[3] *= f[3]; v1[0] *= f[4]; v1[1] *= f[5]; v1[2] *= f[6]; v1[3] *= f[7];
                    acc[ai][bj][m][0] = v0; acc[ai][bj][m][1] = v1;
                    if (u.seg == 2) { u32x4 w; w.x = cvt_pk_bf16(v0[0], v0[1]); w.y = cvt_pk_bf16(v0[2], v0[3]); w.z = cvt_pk_bf16(v1[0], v1[1]); w.w = cvt_pk_bf16(v1[2], v1[3]);
                        *(u32x4*)(O + row * ldc + col0 + bj * HALF) = w; } } }
            asm volatile("" ::: "memory");
        }
    }
};

template <class Epi, class Sched, bool ALIGN_EPI = true, bool FP8 = false>
__device__ __forceinline__ void gemm_phase(LAS unsigned char* lds, const Gemm g, const Sched& S, const Epi& E) {
    int tid_ = threadIdx.x; asm volatile("" : "+v"(tid_));
    const int tid = tid_, wid = __builtin_amdgcn_readfirstlane(tid >> 6), lane = tid & 63, wr = wid >> 2, wc = wid & 3, fr = lane & 15, fq = lane >> 4;
    const int nt = g.K / BK;
    unsigned voffA[2], voffB[2];
#pragma unroll
    for (int i = 0; i < 2; ++i) { int R, C; stage_rc(tid * 16 + i * 8192, R, C); const int Rb = Epi::PERM ? ((R & ~31) + perm32(R & 31)) : R;
        voffA[i] = (unsigned)(R * g.lda + C) * 2u; voffB[i] = (unsigned)(Rb * g.ldb + C) * 2u; }
    const size_t kstep = (size_t)(BK * 2);
    const size_t hstepA = (size_t)HALF * g.lda * 2, hstepB = (size_t)HALF * g.ldb * 2;
    const size_t tstepA = 2 * hstepA, tstepB = 2 * hstepB;
    const unsigned ldsw = (unsigned)wid * 1024u;
    const int aoff = lds_byte(wr * 64 + fr, fq * 8), boff = lds_byte(wc * 32 + fr, fq * 8);
#define PG8_SA(b, h) (((b) * 2 + (h)) * HTB)
#define PG8_SB(b, h) ((4 + (b) * 2 + (h)) * HTB)
#define PG8_STAGE(bufoff, gbase, voff) do { _Pragma("unroll") for (int _i = 0; _i < 2; ++_i) \
        __builtin_amdgcn_global_load_lds((const unsigned*)((const char*)(gbase) + (voff)[_i]), (LAS unsigned*)(lds + (bufoff) + ldsw + _i * 8192), 16, 0, 0); } while (0)
#define PG8_LDA(dst, b, h) do { _Pragma("unroll") for (int m = 0; m < 4; ++m) { \
        if constexpr (FP8) { dst##8[m].lo = *(const LAS v4i*)(lds + PG8_SA(b, h) + aoff + m * 2048); dst##8[m].hi = *(const LAS v4i*)(lds + PG8_SA(b, h) + aoff + m * 2048 + 1024); } \
        else { _Pragma("unroll") for (int k = 0; k < 2; ++k) dst[m][k] = *(const LAS bf16x8*)(lds + PG8_SA(b, h) + aoff + m * 2048 + k * 1024); } } } while (0)
#define PG8_LDB(dst, b, h) do { _Pragma("unroll") for (int n = 0; n < 2; ++n) { \
        if constexpr (FP8) { dst##8[n].lo = *(const LAS v4i*)(lds + PG8_SB(b, h) + boff + n * 2048); dst##8[n].hi = *(const LAS v4i*)(lds + PG8_SB(b, h) + boff + n * 2048 + 1024); } \
        else { _Pragma("unroll") for (int k = 0; k < 2; ++k) dst[n][k] = *(const LAS bf16x8*)(lds + PG8_SB(b, h) + boff + n * 2048 + k * 1024); } } } while (0)
#define PG8_MMA(ai, bj, At, Bt) do { __builtin_amdgcn_s_setprio(1); _Pragma("unroll") for (int m = 0; m < 4; ++m) _Pragma("unroll") for (int n = 0; n < 2; ++n) { \
        if constexpr (FP8) asm volatile("v_mfma_scale_f32_16x16x128_f8f6f4 %0, %1, %2, %0, %3, %3 op_sel_hi:[0,0,0]" : "+v"(acc[ai][bj][m][n]) : "v"(Bt##8[n]), "v"(At##8[m]), "v"(sc7f)); \
        else { _Pragma("unroll") for (int k = 0; k < 2; ++k) acc[ai][bj][m][n] = __builtin_amdgcn_mfma_f32_16x16x32_bf16(Bt[n][k], At[m][k], acc[ai][bj][m][n], 0, 0, 0); } } \
        __builtin_amdgcn_s_setprio(0); } while (0)
#define PG8_WAIT_V(n) asm volatile("s_waitcnt vmcnt(" #n ")" ::: "memory")
#define PG8_WAIT_L(n) asm volatile("s_waitcnt lgkmcnt(" #n ")" ::: "memory")
#define PG8_BAR __builtin_amdgcn_s_barrier()
#define PG8_SCHED __builtin_amdgcn_sched_barrier(0)
    Unit cur, nxt; int ui = 0;
    if (!S.next(0, cur)) return;
    f32x4 acc[2][2][4][2];
#pragma unroll
    for (int a = 0; a < 2; ++a)
#pragma unroll
        for (int b = 0; b < 2; ++b)
#pragma unroll
            for (int m = 0; m < 4; ++m)
#pragma unroll
                for (int n = 0; n < 2; ++n) acc[a][b][m][n] = (f32x4){0.f, 0.f, 0.f, 0.f};
    const int sc7f = 0x7F7F7F7F;
    bf16x8 At[4][2], B0[2][2], B1[2][2];
    v8i At8[4], B08[2], B18[2];
    const char* cA = (const char*)g.A + (size_t)cur.pm * tstepA + (size_t)cur.kofs * 2; const char* cB = (const char*)g.Bt + (size_t)cur.pn * tstepB + (size_t)cur.kofs * 2;
    PG8_STAGE(PG8_SB(0, 0), cB, voffB); PG8_STAGE(PG8_SB(0, 1), cB + hstepB, voffB); PG8_STAGE(PG8_SA(0, 0), cA, voffA); PG8_STAGE(PG8_SA(0, 1), cA + hstepA, voffA);
    if (wr == 1) PG8_BAR;
    PG8_WAIT_V(2); PG8_BAR;
    PG8_STAGE(PG8_SB(1, 0), cB + kstep, voffB); PG8_STAGE(PG8_SA(1, 0), cA + kstep, voffA); PG8_STAGE(PG8_SB(1, 1), cB + hstepB + kstep, voffB);
    PG8_WAIT_V(6); PG8_BAR;
    for (;;) {
        const bool has_next = S.next(ui + 1, nxt);
        const char* nA = has_next ? (const char*)g.A + (size_t)nxt.pm * tstepA + (size_t)nxt.kofs * 2 : cA; const char* nB = has_next ? (const char*)g.Bt + (size_t)nxt.pn * tstepB + (size_t)nxt.kofs * 2 : cB;
        const int ntc = cur.nt ? cur.nt : nt;
        for (int t = 0; t < ntc; t += 2) {
            const bool last = (t == ntc - 2);
            const char* a1 = cA + (size_t)(t + 1) * kstep;
            const char* a2 = last ? nA : cA + (size_t)(t + 2) * kstep; const char* b2 = last ? nB : cB + (size_t)(t + 2) * kstep;
            const char* a3 = a2 + kstep; const char* b3 = b2 + kstep;
            PG8_LDB(B0, 0, 0); PG8_LDB(B1, 0, 1); PG8_SCHED; PG8_LDA(At, 0, 0); PG8_STAGE(PG8_SA(1, 1), a1 + hstepA, voffA);
            PG8_WAIT_V(8); PG8_WAIT_L(0); PG8_BAR; PG8_MMA(0, 0, At, B0); PG8_MMA(0, 1, At, B1); PG8_BAR; PG8_SCHED;
            PG8_LDA(At, 0, 1); PG8_STAGE(PG8_SB(0, 0), b2, voffB); PG8_STAGE(PG8_SB(0, 1), b2 + hstepB, voffB); PG8_STAGE(PG8_SA(0, 0), a2, voffA);
            PG8_WAIT_V(8); PG8_WAIT_L(0); PG8_BAR; PG8_MMA(1, 0, At, B0); PG8_MMA(1, 1, At, B1); PG8_BAR; PG8_SCHED;
            PG8_LDB(B0, 1, 0); PG8_LDB(B1, 1, 1); PG8_SCHED; PG8_LDA(At, 1, 0); PG8_STAGE(PG8_SA(0, 1), a2 + hstepA, voffA);
            PG8_WAIT_V(8); PG8_WAIT_L(0); PG8_BAR; PG8_MMA(0, 0, At, B0); PG8_MMA(0, 1, At, B1); PG8_BAR; PG8_SCHED;
            PG8_LDA(At, 1, 1); PG8_STAGE(PG8_SB(1, 0), b3, voffB); PG8_STAGE(PG8_SB(1, 1), b3 + hstepB, voffB); PG8_STAGE(PG8_SA(1, 0), a3, voffA);
            PG8_WAIT_V(8); PG8_WAIT_L(0); PG8_BAR; PG8_MMA(1, 0, At, B0); PG8_MMA(1, 1, At, B1); PG8_BAR; PG8_SCHED;
        }
        if constexpr (ALIGN_EPI) { if (wr == 0) PG8_BAR; }
        if constexpr (FP8) asm volatile("s_nop 15\n\ts_nop 15" ::: "memory");
        E(acc, cur, wr, wc, fr, fq);
        if (!has_next) break;
        if (cur.seg == 2) {
#pragma unroll
        for (int a = 0; a < 2; ++a)
#pragma unroll
            for (int b = 0; b < 2; ++b)
#pragma unroll
                for (int m = 0; m < 4; ++m)
#pragma unroll
                    for (int n = 0; n < 2; ++n) acc[a][b][m][n] = (f32x4){0.f, 0.f, 0.f, 0.f};
        }
        cur = nxt; cA = nA; cB = nB; ++ui;
        if constexpr (ALIGN_EPI) { if (wr == 1) PG8_BAR; }
    }
    PG8_WAIT_V(0);
    if constexpr (!ALIGN_EPI) { if (wr == 0) PG8_BAR; }
    PG8_BAR;
#undef PG8_SA
#undef PG8_SB
#undef PG8_STAGE
#undef PG8_LDA
#undef PG8_LDB
#undef PG8_MMA
#undef PG8_WAIT_V
#undef PG8_WAIT_L
#undef PG8_BAR
#undef PG8_SCHED
}
}

namespace att {
constexpr int NW = 8, QBLK = 32, KVBLK = 64;
constexpr float SCALE = 0.088388347648318440f, INV_SCALE = 11.313708498984761f;
constexpr float THR = 8.f;
constexpr int SHM_V = KVBLK * 128 * 2, SHM_K = KVBLK * 128 * 2;
constexpr int OFF_WS = 2 * SHM_V + 2 * SHM_K, OFF_TAB = OFF_WS + NW * 64 * 4, TAB_STRIDE = 264, OFF_Q = OFF_TAB + 2 * TAB_STRIDE * 4, LDS_BYTES = OFF_Q + 16;
#define KSWZ(row, colB) ((row) * 256 + ((colB) ^ (((row) & 7) << 4)))
#define SBAR() __builtin_amdgcn_sched_barrier(0)
__device__ __forceinline__ int crow(int r, int hi) { return (r & 3) + 8 * (r >> 2) + 4 * hi; }

__device__ __forceinline__ void partialSM(f32x16& p0, f32x16& p1, float& m_reg, float& mn, float& alpha) {
  constexpr float C = SCALE * 1.4426950408889634f;
  float pmax = p0[0];
#pragma unroll
  for (int r = 1; r < 16; ++r) pmax = fmaxf(pmax, p0[r]);
#pragma unroll
  for (int r = 0; r < 16; ++r) pmax = fmaxf(pmax, p1[r]);
  { auto rr = __builtin_amdgcn_permlane32_swap(__float_as_uint(pmax), __float_as_uint(pmax), false, false);
    pmax = fmaxf(__uint_as_float(rr[0]), __uint_as_float(rr[1])); }
  if (__builtin_expect(__all(pmax - m_reg <= THR / SCALE), 1)) { mn = m_reg; alpha = 1.f; }
  else { mn = fmaxf(m_reg, pmax); alpha = __builtin_amdgcn_exp2f((m_reg - mn) * C); m_reg = mn; }
  float mnC = -mn * C;
#pragma unroll
  for (int r = 0; r < 16; ++r) p0[r] = fmaf(p0[r], C, mnC);
#pragma unroll
  for (int r = 0; r < 16; ++r) p1[r] = fmaf(p1[r], C, mnC);
#pragma unroll
  for (int r = 0; r < 16; ++r) p0[r] = __builtin_amdgcn_exp2f(p0[r]);
}
__device__ __forceinline__ void finishSM(f32x16& p0, f32x16& p1, float alpha, float& l_reg, bf16x8& pa0, bf16x8& pa1, bf16x8& pa2, bf16x8& pa3) {
#pragma unroll
  for (int r = 0; r < 16; ++r) p1[r] = __builtin_amdgcn_exp2f(p1[r]);
  float ps = 0;
#pragma unroll
  for (int r = 0; r < 16; ++r) ps += p0[r];
#pragma unroll
  for (int r = 0; r < 16; ++r) ps += p1[r];
  { auto rr = __builtin_amdgcn_permlane32_swap(__float_as_uint(ps), __float_as_uint(ps), false, false);
    ps = __uint_as_float(rr[0]) + __uint_as_float(rr[1]); }
  l_reg = l_reg * alpha + ps;
#define PK4(P, BASE, OUT) do { unsigned a0 = cvt_pk_bf16(P[BASE + 0], P[BASE + 1]), a1 = cvt_pk_bf16(P[BASE + 2], P[BASE + 3]);   \
    unsigned b0 = cvt_pk_bf16(P[BASE + 4], P[BASE + 5]), b1 = cvt_pk_bf16(P[BASE + 6], P[BASE + 7]);                              \
    auto r0 = __builtin_amdgcn_permlane32_swap(a0, b0, false, false); auto r1 = __builtin_amdgcn_permlane32_swap(a1, b1, false, false); \
    u32x4 w = {r0[0], r1[0], r0[1], r1[1]}; OUT = *reinterpret_cast<bf16x8*>(&w); } while (0)
  PK4(p0, 0, pa0); PK4(p0, 8, pa1); PK4(p1, 0, pa2); PK4(p1, 8, pa3);
#undef PK4
}
__device__ __forceinline__ void qkt(f32x16& p0, f32x16& p1, const bf16_t* Ks, const bf16x8* qr, int r32, int hi) {
  p0 = f32x16{}; p1 = f32x16{};
#pragma unroll
  for (int d0 = 0; d0 < 8; ++d0) { int cb = (d0 * 16 + hi * 8) * 2;
    bf16x8 b0 = *reinterpret_cast<const bf16x8*>((const char*)Ks + KSWZ(r32, cb));
    bf16x8 b1 = *reinterpret_cast<const bf16x8*>((const char*)Ks + KSWZ(32 + r32, cb));
    p0 = __builtin_amdgcn_mfma_f32_32x32x16_bf16(b0, qr[d0], p0, 0, 0, 0);
    p1 = __builtin_amdgcn_mfma_f32_32x32x16_bf16(b1, qr[d0], p1, 0, 0, 0); }
}
__device__ __forceinline__ void maskbias_half(f32x16& p, int kb, int qpos, int hw, int L, const float* tab, int hi) {
  float bv[16];
#pragma unroll
  for (int r = 0; r < 16; ++r) { const int ri = kb + crow(r, hi) - qpos + hw; bv[r] = tab[min(max(ri, 0), 2 * hw)]; }
#pragma unroll
  for (int r = 0; r < 16; ++r) asm volatile("" : "+v"(bv[r]));
#pragma unroll
  for (int r = 0; r < 16; ++r) { const int key = kb + crow(r, hi); const int ri = key - qpos + hw;
    const bool ok = ((unsigned)ri <= (unsigned)(2 * hw)) && ((unsigned)key < (unsigned)L);
    p[r] = ok ? p[r] + bv[r] : -1e30f; }
}
__device__ __forceinline__ void maskbias(f32x16& p0, f32x16& p1, int kbase, int qpos, int hw, int L, const float* tab, int hi) {
  maskbias_half(p0, kbase, qpos, hw, L, tab, hi); maskbias_half(p1, kbase + 32, qpos, hw, L, tab, hi);
}
__device__ __forceinline__ int v_st(int k, int c) { const int kk = (k & ~0xC) | ((k & 4) << 1) | ((k & 8) >> 1); return ((kk >> 3) * 4 + (c >> 5)) * 512 + ((kk & 7) * 32 + (c & 31)) * 2; }
__device__ __forceinline__ int v_rd_base(int lane) { return ((lane & 3) << 3) | (((lane >> 2) & 3) << 6) | (((lane >> 4) & 1) << 5) | (((lane >> 5) & 1) << 8); }
constexpr int v_rd_off(int d0, int ks, int half) { return d0 * 512 + ks * 4096 + half * 2048; }
template <int OFF> __device__ __forceinline__ s16x4 tr_read(int vb) {
  s16x4 r; asm volatile("ds_read_b64_tr_b16 %0, %1 offset:%2" : "=&v"(r) : "v"(vb), "i"(OFF) : "memory"); return r;
}
template <int D0> __device__ __forceinline__ void pv_one(f32x16& od, int vb, bf16x8 pa0, bf16x8 pa1, bf16x8 pa2, bf16x8 pa3) {
  const s16x4 l0 = tr_read<v_rd_off(D0, 0, 0)>(vb), h0 = tr_read<v_rd_off(D0, 0, 1)>(vb), l1 = tr_read<v_rd_off(D0, 1, 0)>(vb), h1 = tr_read<v_rd_off(D0, 1, 1)>(vb);
  const s16x4 l2 = tr_read<v_rd_off(D0, 2, 0)>(vb), h2 = tr_read<v_rd_off(D0, 2, 1)>(vb), l3 = tr_read<v_rd_off(D0, 3, 0)>(vb), h3 = tr_read<v_rd_off(D0, 3, 1)>(vb);
  asm volatile("s_waitcnt lgkmcnt(0)" ::: "memory"); SBAR();
#define PK(L, H) (bf16x8){L[0], L[1], L[2], L[3], H[0], H[1], H[2], H[3]}
  od = __builtin_amdgcn_mfma_f32_32x32x16_bf16(pa0, PK(l0, h0), od, 0, 0, 0);
  od = __builtin_amdgcn_mfma_f32_32x32x16_bf16(pa1, PK(l1, h1), od, 0, 0, 0);
  od = __builtin_amdgcn_mfma_f32_32x32x16_bf16(pa2, PK(l2, h2), od, 0, 0, 0);
  od = __builtin_amdgcn_mfma_f32_32x32x16_bf16(pa3, PK(l3, h3), od, 0, 0, 0);
#undef PK
}
__device__ __forceinline__ void pv_d0(f32x16* o, int vb, bf16x8 pa0, bf16x8 pa1, bf16x8 pa2, bf16x8 pa3) {
  pv_one<0>(o[0], vb, pa0, pa1, pa2, pa3); pv_one<1>(o[1], vb, pa0, pa1, pa2, pa3); pv_one<2>(o[2], vb, pa0, pa1, pa2, pa3); pv_one<3>(o[3], vb, pa0, pa1, pa2, pa3);
}

struct AttnP {
  const bf16_t* Qw;
  const bf16_t* Kb; const bf16_t* Vb;
  long ks;
  int k0, NT, L;
  int qpos, hw;
  const float* tab;
  float sink; int has_sink;
  int omode;
  unsigned char* Yp; long ys;
  float* Cp; long cs; float* Lp; long ls;
};

#ifndef ATT_SDEPTH
#define ATT_SDEPTH 1
#endif
template <int MODE>
__device__ __forceinline__ void attn_body(const AttnP& P, char* lds) {
  int tid_ = threadIdx.x; asm volatile("" : "+v"(tid_));
  const int tid = tid_, wid = tid >> 6, lane = tid & 63, r32 = lane & 31, hi = lane >> 5;
  bf16_t* V_lds = (bf16_t*)lds; bf16_t* K_lds = (bf16_t*)(lds + 2 * SHM_V);
  float* ws = (float*)(lds + OFF_WS) + wid * 64; float* li_l = ws; float* al_l = ws + 32;
  float m_reg = -1e4f, l_reg = 0; f32x16 o[4] = {}; bf16x8 qr[8];
#pragma unroll
  for (int d0 = 0; d0 < 8; ++d0) qr[d0] = *reinterpret_cast<const bf16x8*>(P.Qw + d0 * 16);
  const int sr = tid >> 4, sc = (tid & 15) * 8, vst0 = v_st(sr, sc), vst1 = v_st(32 + sr, sc);
  const int vb0 = (int)(uintptr_t)V_lds + v_rd_base(lane);
  constexpr int SDEPTH = ATT_SDEPTH;
  struct { bf16x8 vs0, vs1, ks0, ks1; } sr_[SDEPTH];
#define KROW(kp) (MODE ? min(max((kp), 0), P.L - 1) : (kp))
#define SLOAD(i, t_) do { const int kk0_ = P.k0 + (t_) * KVBLK; const long ra_ = (long)KROW(kk0_ + sr) * (MODE ? P.ks : (long)3840) + sc, rb_ = (long)KROW(kk0_ + 32 + sr) * (MODE ? P.ks : (long)3840) + sc; \
    sr_[i].vs0 = *reinterpret_cast<const bf16x8*>(P.Vb + ra_); sr_[i].vs1 = *reinterpret_cast<const bf16x8*>(P.Vb + rb_); \
    sr_[i].ks0 = *reinterpret_cast<const bf16x8*>(P.Kb + ra_); sr_[i].ks1 = *reinterpret_cast<const bf16x8*>(P.Kb + rb_); } while (0)
#define SWRITE(b, i) do { *(bf16x8*)((char*)V_lds + (b) * SHM_V + vst0) = sr_[i].vs0;          \
    *(bf16x8*)((char*)V_lds + (b) * SHM_V + vst1) = sr_[i].vs1; int kc = sc * 2;               \
    *(bf16x8*)((char*)K_lds + (b) * SHM_K + KSWZ(sr, kc)) = sr_[i].ks0;                       \
    *(bf16x8*)((char*)K_lds + (b) * SHM_K + KSWZ(32 + sr, kc)) = sr_[i].ks1; } while (0)
#define SWAIT() do { if constexpr (SDEPTH == 2) asm volatile("s_waitcnt vmcnt(4)" ::: "memory"); else asm volatile("s_waitcnt vmcnt(0)" ::: "memory"); } while (0)
#define RESC(a) do { if (__any((a) < 1.f)) { if (hi == 0) al_l[r32] = (a); asm volatile("s_waitcnt lgkmcnt(0)" ::: "memory"); \
    _Pragma("unroll") for (int d = 0; d < 4; ++d) _Pragma("unroll") for (int r = 0; r < 16; ++r) o[d][r] *= al_l[crow(r, hi)]; } } while (0)
#define MB(p0_, p1_, t_) do { if (MODE) maskbias(p0_, p1_, P.k0 + (t_) * KVBLK, P.qpos, P.hw, P.L, P.tab, hi); } while (0)
  f32x16 pA0, pA1, pB0, pB1; float mnA, mnB, alA, alB; bf16x8 pa0, pa1, pa2, pa3; const int NT = P.NT;
  constexpr int SE = 0, SO = SDEPTH - 1;
  SLOAD(SE, 0); asm volatile("s_waitcnt vmcnt(0)" ::: "memory"); SWRITE(0, SE); __syncthreads();
  qkt(pA0, pA1, K_lds, qr, r32, hi); MB(pA0, pA1, 0); partialSM(pA0, pA1, m_reg, mnA, alA);
  SLOAD(SO, 1); if constexpr (SDEPTH == 2) { if (2 < NT) SLOAD(SE, 2); }
  SWAIT(); SWRITE(1, SO); __syncthreads();
  for (int j = 1; j + 1 < NT; j += 2) {
    SBAR(); qkt(pB0, pB1, (bf16_t*)((char*)K_lds + SHM_K), qr, r32, hi); MB(pB0, pB1, j);
    finishSM(pA0, pA1, alA, l_reg, pa0, pa1, pa2, pa3); SBAR();
    SLOAD(SO, (j + SDEPTH < NT) ? j + SDEPTH : j); SBAR();
    pv_d0(o, vb0, pa0, pa1, pa2, pa3); partialSM(pB0, pB1, m_reg, mnB, alB);
    __syncthreads(); SWAIT(); SWRITE(0, SE);
    RESC(alB); __syncthreads();
    SBAR(); qkt(pA0, pA1, K_lds, qr, r32, hi); MB(pA0, pA1, j + 1);
    finishSM(pB0, pB1, alB, l_reg, pa0, pa1, pa2, pa3); SBAR();
    if (SDEPTH == 1 || j + 3 < NT) SLOAD(SE, j + 1 + SDEPTH); SBAR();
    pv_d0(o, vb0 + (int)SHM_V, pa0, pa1, pa2, pa3); partialSM(pA0, pA1, m_reg, mnA, alA);
    __syncthreads(); SWAIT(); SWRITE(1, SO);
    RESC(alA); __syncthreads();
  }
  SBAR(); qkt(pB0, pB1, (bf16_t*)((char*)K_lds + SHM_K), qr, r32, hi); MB(pB0, pB1, NT - 1);
  finishSM(pA0, pA1, alA, l_reg, pa0, pa1, pa2, pa3); SBAR();
  pv_d0(o, vb0, pa0, pa1, pa2, pa3); partialSM(pB0, pB1, m_reg, mnB, alB);
  __syncthreads(); RESC(alB);
  finishSM(pB0, pB1, alB, l_reg, pa0, pa1, pa2, pa3); SBAR();
  pv_d0(o, vb0 + (int)SHM_V, pa0, pa1, pa2, pa3);
  asm volatile("s_waitcnt vmcnt(0)" ::: "memory");
  if (MODE) { if (P.has_sink) l_reg += __builtin_amdgcn_exp2f((P.sink - m_reg * SCALE) * LOG2E); }
  if (hi == 0) li_l[r32] = l_reg; asm volatile("s_waitcnt lgkmcnt(0)" ::: "memory");
  float rli[16];
#pragma unroll
  for (int r = 0; r < 16; ++r) rli[r] = __builtin_amdgcn_rcpf(li_l[crow(r, hi)]);
  if (!MODE || P.omode == 0) {
#pragma unroll
    for (int r = 0; r < 16; ++r) { const int orow = crow(r, hi);
#pragma unroll
      for (int d0 = 0; d0 < 4; ++d0) P.Yp[(long)orow * (MODE ? P.ys : (long)1536) + d0 * 32 + r32] = cvt1_fp8(o[d0][r] * rli[r] * Y8_SCALE); }
  } else {
#pragma unroll
    for (int r = 0; r < 16; ++r) { const int orow = crow(r, hi);
#pragma unroll
      for (int d0 = 0; d0 < 4; ++d0) P.Cp[(long)orow * P.cs + d0 * 32 + r32] = o[d0][r] * rli[r]; }
    if (hi == 0) P.Lp[(long)r32 * P.ls] = m_reg * SCALE + __logf(l_reg);
  }
#undef KROW
#undef SLOAD
#undef SWRITE
#undef SWAIT
#undef RESC
#undef MB
}

__device__ __forceinline__ void attn_banded(const AttnP& P, char* lds) {
  int tid_ = threadIdx.x; asm volatile("" : "+v"(tid_));
  const int tid = tid_, wid = tid >> 6, lane = tid & 63, r32 = lane & 31, hi = lane >> 5;
  bf16_t* V_lds = (bf16_t*)lds; bf16_t* K_lds = (bf16_t*)(lds + 2 * SHM_V);
  float* ws = (float*)(lds + OFF_WS) + wid * 64; float* li_l = ws; float* al_l = ws + 32;
  float m_reg = -1e4f, l_reg = 0; f32x16 o[4] = {}; bf16x8 qr[8];
#pragma unroll
  for (int d0 = 0; d0 < 8; ++d0) qr[d0] = *reinterpret_cast<const bf16x8*>(P.Qw + d0 * 16);
  const int sr = tid >> 4, sc = (tid & 15) * 8, vst0 = v_st(sr, sc), vst1 = v_st(32 + sr, sc);
  const int vb0 = (int)(uintptr_t)V_lds + v_rd_base(lane);
  bf16x8 vs0, vs1, ks0, ks1;
#define KROW(kp) min(max((kp), 0), P.L - 1)
#define SLOAD(t_) do { const int kk0_ = P.k0 + (t_) * KVBLK; const long ra_ = (long)KROW(kk0_ + sr) * P.ks + sc, rb_ = (long)KROW(kk0_ + 32 + sr) * P.ks + sc; \
    vs0 = *reinterpret_cast<const bf16x8*>(P.Vb + ra_); vs1 = *reinterpret_cast<const bf16x8*>(P.Vb + rb_); \
    ks0 = *reinterpret_cast<const bf16x8*>(P.Kb + ra_); ks1 = *reinterpret_cast<const bf16x8*>(P.Kb + rb_); } while (0)
#define SWRITE(b) do { *(bf16x8*)((char*)V_lds + (b) * SHM_V + vst0) = vs0; *(bf16x8*)((char*)V_lds + (b) * SHM_V + vst1) = vs1; const int kc = sc * 2; \
    *(bf16x8*)((char*)K_lds + (b) * SHM_K + KSWZ(sr, kc)) = ks0; *(bf16x8*)((char*)K_lds + (b) * SHM_K + KSWZ(32 + sr, kc)) = ks1; } while (0)
  SLOAD(0); asm volatile("s_waitcnt vmcnt(0)" ::: "memory"); SWRITE(0);
  const int NT = P.NT;
  for (int t = 0; t < NT; ++t) {
    const int b = t & 1;
    if (t + 1 < NT) SLOAD(t + 1);
    __syncthreads();
    f32x16 p0, p1; float mn, al; bf16x8 pa0, pa1, pa2, pa3;
    qkt(p0, p1, (bf16_t*)((char*)K_lds + b * SHM_K), qr, r32, hi);
    maskbias(p0, p1, P.k0 + t * KVBLK, P.qpos, P.hw, P.L, P.tab, hi);
    partialSM(p0, p1, m_reg, mn, al);
    if (__any(al < 1.f)) { if (hi == 0) al_l[r32] = al; asm volatile("s_waitcnt lgkmcnt(0)" ::: "memory");
#pragma unroll
      for (int d = 0; d < 4; ++d)
#pragma unroll
        for (int r = 0; r < 16; ++r) o[d][r] *= al_l[crow(r, hi)]; }
    finishSM(p0, p1, al, l_reg, pa0, pa1, pa2, pa3); SBAR();
    pv_d0(o, vb0 + b * (int)SHM_V, pa0, pa1, pa2, pa3);
    if (t + 1 < NT) { asm volatile("s_waitcnt vmcnt(0)" ::: "memory"); SWRITE(b ^ 1); }
  }
  if (P.has_sink) l_reg += __builtin_amdgcn_exp2f((P.sink - m_reg * SCALE) * LOG2E);
  if (hi == 0) li_l[r32] = l_reg; asm volatile("s_waitcnt lgkmcnt(0)" ::: "memory");
  float rli[16];
#pragma unroll
  for (int r = 0; r < 16; ++r) rli[r] = __builtin_amdgcn_rcpf(li_l[crow(r, hi)]);
  if (P.omode == 0) {
#pragma unroll
    for (int r = 0; r < 16; ++r) { const int orow = crow(r, hi);
#pragma unroll
      for (int d0 = 0; d0 < 4; ++d0) P.Yp[(long)orow * P.ys + d0 * 32 + r32] = cvt1_fp8(o[d0][r] * rli[r] * Y8_SCALE); }
  } else {
#pragma unroll
    for (int r = 0; r < 16; ++r) { const int orow = crow(r, hi);
#pragma unroll
      for (int d0 = 0; d0 < 4; ++d0) P.Cp[(long)orow * P.cs + d0 * 32 + r32] = o[d0][r] * rli[r]; }
    if (hi == 0) P.Lp[(long)r32 * P.ls] = m_reg * SCALE + __logf(l_reg);
  }
#undef KROW
#undef SLOAD
#undef SWRITE
}
}

constexpr size_t MiB = 1u << 20;
constexpr size_t WS_CTL = 0, WS_W13A = 1 * MiB, WS_W2A = 45 * MiB, WS_WIN = 67 * MiB, WS_WG = 82 * MiB, WS_WBR = 106 * MiB, WS_WO = 112 * MiB,
                 WS_W13B = 120 * MiB, WS_W2B = 164 * MiB, WS_H = 186 * MiB, WS_R1 = 250 * MiB, WS_Z = WS_R1, WS_Y = 370 * MiB, WS_MRG = 418 * MiB,
                 WS_HID = WS_R1, WS_CO = WS_MRG, WS_CLSE = WS_MRG + 48 * MiB, WS_GATES = 482 * MiB, WS_XB8 = 674 * MiB, WS_WG8 = 706 * MiB, WS_Y8 = 718 * MiB, WS_WBR8 = 742 * MiB, WS_END = 746 * MiB;
constexpr int RING_BYTES = 131072, LDS_BYTES = 147456;
static_assert(att::LDS_BYTES <= RING_BYTES, "attention LDS fits in the ring");

struct Params { const float* in[21]; float* out; unsigned char* ws; };

__device__ __forceinline__ float wave_sum(float v) {
#pragma unroll
    for (int o = 1; o < 64; o <<= 1) v += __shfl_xor(v, o);
    return v;
}

__device__ __forceinline__ void cvt_item(const float* __restrict__ W, int N, bf16_t* __restrict__ WT, int ldw, int koff, int mode, LAS float* scr, int item, int lane, const float* __restrict__ gain = nullptr) {
    const int nblk = N / 32, kb = item / nblk, nb = item - kb * nblk, k0 = 64 * kb, n0 = 32 * nb;
    const int lr = lane >> 3, lc = (lane & 7) * 4;
    f32x4 v[8];
#pragma unroll
    for (int i = 0; i < 8; ++i) v[i] = *(const f32x4*)(W + (size_t)(k0 + 8 * i + lr) * N + n0 + lc);
#pragma unroll
    for (int i = 0; i < 8; ++i) { const float gk = gain ? gain[k0 + 8 * i + lr] : 1.0f; LAS float* s = scr + (8 * i + lr) * 33 + lc; s[0] = v[i].x * gk; s[1] = v[i].y * gk; s[2] = v[i].z * gk; s[3] = v[i].w * gk; }
    LDS_WAIT();
    int drow0 = n0;
    if (mode == 1) { const int bj = n0 / DFF, rem = n0 - bj * DFF, pn = rem >> 7, c = rem & 127; drow0 = 256 * pn + 128 * bj + c; }
    const int c = lane & 7;
#pragma unroll
    for (int j = 0; j < 4; ++j) { const int n = (lane >> 3) + 8 * j; const LAS float* s = scr + (8 * c) * 33 + n;
        u32x4 o; o.x = cvt_pk_bf16(s[0 * 33], s[1 * 33]); o.y = cvt_pk_bf16(s[2 * 33], s[3 * 33]); o.z = cvt_pk_bf16(s[4 * 33], s[5 * 33]); o.w = cvt_pk_bf16(s[6 * 33], s[7 * 33]);
        *(u32x4*)(WT + (size_t)(drow0 + n) * ldw + koff + k0 + 8 * c) = o; }
    LDS_WAIT();
}


__device__ __forceinline__ u32x2 cvt8_fp8(float a0, float a1, float a2, float a3, float a4, float a5, float a6, float a7) {
    int w0 = __builtin_amdgcn_cvt_pk_fp8_f32(a0, a1, 0, false); w0 = __builtin_amdgcn_cvt_pk_fp8_f32(a2, a3, w0, true);
    int w1 = __builtin_amdgcn_cvt_pk_fp8_f32(a4, a5, 0, false); w1 = __builtin_amdgcn_cvt_pk_fp8_f32(a6, a7, w1, true);
    u32x2 r; r.x = (unsigned)w0; r.y = (unsigned)w1; return r;
}
constexpr float WG8_SCALE = 64.0f;
__device__ __forceinline__ void cvt_item_fp8(const float* __restrict__ W, int N, unsigned char* __restrict__ WT, int ldw, LAS float* scr, int item, int lane, const float* __restrict__ gain, int koff = 0, float scale = WG8_SCALE) {
    const int nblk = N / 32, kb = item / nblk, nb = item - kb * nblk, k0 = 64 * kb, n0 = 32 * nb;
    const int lr = lane >> 3, lc = (lane & 7) * 4;
    f32x4 v[8];
#pragma unroll
    for (int i = 0; i < 8; ++i) v[i] = *(const f32x4*)(W + (size_t)(k0 + 8 * i + lr) * N + n0 + lc);
#pragma unroll
    for (int i = 0; i < 8; ++i) { const float gk = (gain ? gain[k0 + 8 * i + lr] : 1.0f) * scale; LAS float* s = scr + (8 * i + lr) * 33 + lc; s[0] = v[i].x * gk; s[1] = v[i].y * gk; s[2] = v[i].z * gk; s[3] = v[i].w * gk; }
    LDS_WAIT();
    const int c = lane & 7;
#pragma unroll
    for (int j = 0; j < 4; ++j) { const int n = (lane >> 3) + 8 * j; const LAS float* s = scr + (8 * c) * 33 + n;
        *(u32x2*)(WT + (size_t)(n0 + n) * ldw + koff + k0 + 8 * c) = cvt8_fp8(s[0 * 33], s[1 * 33], s[2 * 33], s[3 * 33], s[4 * 33], s[5 * 33], s[6 * 33], s[7 * 33]); }
    LDS_WAIT();
}

template <bool COPY>
__device__ __forceinline__ void rms_row_bf16(const float* __restrict__ xrow, const float* __restrict__ gain, bf16_t* __restrict__ orow, float* __restrict__ xcopy, int lane) {
    const f32x4* xr = (const f32x4*)xrow + lane;
    f32x4 v[8]; float s = 0.f;
#pragma unroll
    for (int j = 0; j < 8; ++j) { v[j] = xr[64 * j]; s += (v[j].x * v[j].x + v[j].y * v[j].y) + (v[j].z * v[j].z + v[j].w * v[j].w); }
    if (COPY) {
#pragma unroll
        for (int j = 0; j < 8; ++j) ((f32x4*)xcopy + lane)[64 * j] = v[j]; }
    const float rs = 1.0f / sqrtf(wave_sum(s) * (1.f / DM) + NORM_EPS);
    const f32x4* gr = (const f32x4*)gain + lane;
    u32x2* o8 = (u32x2*)orow + lane;
#pragma unroll
    for (int j = 0; j < 8; ++j) { const f32x4 g = gr[64 * j]; u32x2 w; w.x = cvt_pk_bf16(v[j].x * rs * g.x, v[j].y * rs * g.y); w.y = cvt_pk_bf16(v[j].z * rs * g.z, v[j].w * rs * g.w); o8[64 * j] = w; }
}
__device__ __forceinline__ void x_row_init(const float* __restrict__ xrow, float* __restrict__ xcopy, bf16_t* __restrict__ xb, float* __restrict__ ssq_row, int lane) {
    const f32x4* xr = (const f32x4*)xrow + lane;
    f32x4 v[8]; float s = 0.f;
#pragma unroll
    for (int j = 0; j < 8; ++j) { v[j] = xr[64 * j]; s += (v[j].x * v[j].x + v[j].y * v[j].y) + (v[j].z * v[j].z + v[j].w * v[j].w); }
#pragma unroll
    for (int j = 0; j < 8; ++j) ((f32x4*)xcopy + lane)[64 * j] = v[j];
    u32x2* o8 = (u32x2*)xb + lane;
#pragma unroll
    for (int j = 0; j < 8; ++j) { u32x2 w; w.x = cvt_pk_bf16(v[j].x, v[j].y); w.y = cvt_pk_bf16(v[j].z, v[j].w); o8[64 * j] = w; }
    s = wave_sum(s);
    if (lane == 0) *ssq_row = s;
}
__device__ __forceinline__ void rms_row_f32(float* __restrict__ xrow, const float* __restrict__ gain, int lane) {
    f32x4* xr = (f32x4*)xrow + lane;
    f32x4 v[8]; float s = 0.f;
#pragma unroll
    for (int j = 0; j < 8; ++j) { v[j] = xr[64 * j]; s += (v[j].x * v[j].x + v[j].y * v[j].y) + (v[j].z * v[j].z + v[j].w * v[j].w); }
    const float rs = 1.0f / sqrtf(wave_sum(s) * (1.f / DM) + NORM_EPS);
    const f32x4* gr = (const f32x4*)gain + lane;
#pragma unroll
    for (int j = 0; j < 8; ++j) { const f32x4 g = gr[64 * j]; f32x4 w; w.x = v[j].x * rs * g.x; w.y = v[j].y * rs * g.y; w.z = v[j].z * rs * g.z; w.w = v[j].w * rs * g.w; xr[64 * j] = w; }
}

__device__ __forceinline__ int t5_bucket(int rel) {
    const int n = rel < 0 ? -rel : rel;
    int b = n;
    if (n >= 8) { b = 5 + (31 - __clz(n)); b = b < 15 ? b : 15; }
    return (rel > 0 ? 16 : 0) + b;
}


#define XB_TMO      128
#define XB_XCNT(j)  (256  + 64 * (j))
#define XB_XSUB(j)  (1280 + 64 * (j))
#define XB_XGEN(j)  (2304 + 64 * (j))
#define XB_TOP      3328
#define XB_TOPGEN   3392
#define XCD_BAR_WORDS 3456
#define XB_SPIN_CAP (1u << 18)

__device__ __forceinline__ unsigned xb_ld(unsigned* p)              { return __hip_atomic_load(p, __ATOMIC_RELAXED, __HIP_MEMORY_SCOPE_AGENT); }
__device__ __forceinline__ unsigned xb_add(unsigned* p, unsigned v) { return __hip_atomic_fetch_add(p, v, __ATOMIC_RELAXED, __HIP_MEMORY_SCOPE_AGENT); }
__device__ __forceinline__ unsigned xb_xcc_id() { return (unsigned)__builtin_amdgcn_s_getreg((3 << 11) | 20) & 0xFu; }
#define XB_SPIN(cond, bar) do { unsigned _sp = 0; while (cond) { __builtin_amdgcn_s_sleep(1); \
    if ((++_sp & 255u) == 0u) { if (xb_ld(&(bar)[XB_TMO])) break; if (_sp > XB_SPIN_CAP) { atomicAdd(&(bar)[XB_TMO], 1u); break; } } } } while (0)

struct XcdBarrier {
    unsigned* bar; unsigned x;
    volatile LAS unsigned* st;
};

__device__ __forceinline__ XcdBarrier xcd_barrier_post(unsigned* bar, volatile LAS unsigned* st) {
    XcdBarrier b; b.bar = bar; b.x = xb_xcc_id(); b.st = st;
    if (threadIdx.x == 0) (void)xb_add(&bar[XB_XCNT(b.x)], 1u);
    return b;
}
__device__ __forceinline__ void xcd_barrier_complete(unsigned* bar, unsigned x, unsigned& nloc, unsigned& nx) {
    const unsigned G = gridDim.x * gridDim.y * gridDim.z;
    unsigned sum, cnt, mine, sp = 0u;
    for (;;) {
        sum = 0u; cnt = 0u; mine = 0u;
#pragma unroll
        for (unsigned j = 0; j < 16; ++j) { const unsigned c = xb_ld(&bar[XB_XCNT(j)]); sum += c; cnt += (c > 0u) ? 1u : 0u; mine = (j == x) ? c : mine; }
        if (sum == G) break;
        __builtin_amdgcn_s_sleep(1);
        if ((++sp & 255u) == 0u) { if (xb_ld(&bar[XB_TMO])) break; if (sp > XB_SPIN_CAP) { atomicAdd(&bar[XB_TMO], 1u); break; } }
    }
    nloc = mine > 0u ? mine : 1u; nx = cnt > 0u ? cnt : 1u;
}

__device__ __forceinline__ void xcd_barrier(const XcdBarrier& b) {
    asm volatile("s_waitcnt vmcnt(0)" ::: "memory");
    __syncthreads();
    if (threadIdx.x == 0) {
        unsigned* bar = b.bar;
        __builtin_amdgcn_s_waitcnt(0);
        unsigned nloc = b.st[0], nx = b.st[1];
        if (nloc == 0u) { xcd_barrier_complete(bar, b.x, nloc, nx); b.st[0] = nloc; b.st[1] = nx; }
        const unsigned old = xb_add(&bar[XB_XSUB(b.x)], 1u);
        const unsigned gen = old / nloc;
        if (old + 1u == (gen + 1u) * nloc) {
            __builtin_amdgcn_fence(__ATOMIC_RELEASE, "agent");
            asm volatile("s_waitcnt vmcnt(0)" ::: "memory");
            const unsigned og = xb_add(&bar[XB_TOP], 1u);
            const unsigned tg = og / nx;
            if (og + 1u == (tg + 1u) * nx) xb_add(&bar[XB_TOPGEN], 1u);
            else XB_SPIN(xb_ld(&bar[XB_TOPGEN]) == tg, bar);
            __builtin_amdgcn_fence(__ATOMIC_ACQUIRE, "agent");
            xb_add(&bar[XB_XGEN(b.x)], 1u);
            asm volatile("s_waitcnt vmcnt(0)" ::: "memory");
        } else {
            XB_SPIN(xb_ld(&bar[XB_XGEN(b.x)]) == gen, bar);
            __builtin_amdgcn_fence(__ATOMIC_ACQUIRE, "agent");
            asm volatile("s_waitcnt vmcnt(0)" ::: "memory");
        }
    }
    __syncthreads();
}


#define GSYNC() xcd_barrier(xbar)


template <int layer>
__device__ __forceinline__ void run_layer(const Params& p, unsigned char* lds, const XcdBarrier& xbar) {
    int tid_ = threadIdx.x; asm volatile("" : "+v"(tid_));
    const int tid = tid_, lane = tid & 63, wave = __builtin_amdgcn_readfirstlane(tid >> 6);
    const int G = gridDim.x, gw = blockIdx.x * 8 + wave, NGW = G * 8;
    unsigned char* ws = p.ws;
    unsigned* ctl = (unsigned*)(ws + WS_CTL);
    bf16_t* H = (bf16_t*)(ws + WS_H); bf16_t* Z = (bf16_t*)(ws + WS_Z); bf16_t* Y = (bf16_t*)(ws + WS_Y); bf16_t* MRG = (bf16_t*)(ws + WS_MRG);
    bf16_t* HID = (bf16_t*)(ws + WS_HID); bf16_t* GATES = (bf16_t*)(ws + WS_GATES); float* CO = (float*)(ws + WS_CO); float* CLSE = (float*)(ws + WS_CLSE);
    bf16_t* W13A = (bf16_t*)(ws + WS_W13A); bf16_t* W2A = (bf16_t*)(ws + WS_W2A); bf16_t* WIN = (bf16_t*)(ws + WS_WIN); unsigned char* WG8 = ws + WS_WG8; unsigned char* XB8 = ws + WS_XB8;
    unsigned char* WBR8 = ws + WS_WBR8; unsigned char* Y8 = ws + WS_Y8; bf16_t* WO = (bf16_t*)(ws + WS_WO); bf16_t* W13B = (bf16_t*)(ws + WS_W13B); bf16_t* W2B = (bf16_t*)(ws + WS_W2B);
    float* X = p.out;
    LAS unsigned char* ldsl = (LAS unsigned char*)lds;
    float* SSQ = (float*)(ws + 65536);
    float* ssqA = SSQ + (size_t)(3 * layer) * MTOK; float* ssqB = ssqA + MTOK; float* ssqC = ssqB + MTOK; float* ssqN = ssqC + MTOK;
    {
        {
            LAS float* scr = (LAS float*)(ldsl + wave * 16384);
            const float* s_w13a = p.in[3] + (size_t)layer * DM * 2 * DFF; const float* s_w2a = p.in[4] + (size_t)layer * DFF * DM;
            const float* s_win = p.in[6] + (size_t)layer * DM * NIN; const float* s_wg = p.in[10] + (size_t)layer * DM * NG;
            const float* s_bra = p.in[12] + (size_t)layer * 512 * DM; const float* s_brb = p.in[13] + (size_t)layer * 768 * DM; const float* s_brc = p.in[14] + (size_t)layer * 256 * DM;
            const float* s_wo = p.in[15] + (size_t)layer * DM * DM;
            const float* s_w13b = p.in[17] + (size_t)layer * DM * 2 * DFF; const float* s_w2b = p.in[18] + (size_t)layer * DFF * DM;
            constexpr int I_13 = (DM / 64) * (2 * DFF / 32), I_2 = (DFF / 64) * (DM / 32), I_IN = (DM / 64) * (NIN / 32), I_G = (DM / 64) * (NG / 32),
                          I_BA = (512 / 64) * (DM / 32), I_BB = (768 / 64) * (DM / 32), I_BC = (256 / 64) * (DM / 32), I_O = (DM / 64) * (DM / 32);
            constexpr int NITEMS = 2 * I_13 + 2 * I_2 + I_IN + I_G + I_BA + I_BB + I_BC + I_O;
            for (int it = gw; it < NITEMS; it += NGW) {
                int r = it;
                if (r < I_13) { cvt_item(s_w13a, 2 * DFF, W13A, DM, 0, 1, scr, r, lane, p.in[2] + (size_t)layer * DM); continue; } r -= I_13;
                if (r < I_2) { cvt_item(s_w2a, DM, W2A, DFF, 0, 0, scr, r, lane); continue; } r -= I_2;
                if (r < I_IN) { cvt_item(s_win, NIN, WIN, DM, 0, 0, scr, r, lane, p.in[5] + (size_t)layer * DM); continue; } r -= I_IN;
                if (r < I_G) { cvt_item_fp8(s_wg, NG, WG8, DM, scr, r, lane, p.in[5] + (size_t)layer * DM); continue; } r -= I_G;
                if (r < I_BA) { cvt_item_fp8(s_bra, DM, WBR8, NY, scr, r, lane, nullptr, 0, Y8_SCALE); continue; } r -= I_BA;
                if (r < I_BB) { cvt_item_fp8(s_brb, DM, WBR8, NY, scr, r, lane, nullptr, 512, Y8_SCALE); continue; } r -= I_BB;
                if (r < I_BC) { cvt_item_fp8(s_brc, DM, WBR8, NY, scr, r, lane, nullptr, 1280, Y8_SCALE); continue; } r -= I_BC;
                if (r < I_O) { cvt_item(s_wo, DM, WO, DM, 0, 0, scr, r, lane); continue; } r -= I_O;
                if (r < I_13) { cvt_item(s_w13b, 2 * DFF, W13B, DM, 0, 1, scr, r, lane, p.in[16] + (size_t)layer * DM); continue; } r -= I_13;
                cvt_item(s_w2b, DM, W2B, DFF, 0, 0, scr, r, lane);
            }
            if (layer == 0) {
                for (int m = gw; m < MTOK; m += NGW) { const float* src = m < 8192 ? p.in[0] + (size_t)m * DM : p.in[1] + (size_t)(m - 8192) * DM;
                    x_row_init(src, X + (size_t)m * DM, H + (size_t)m * DM, ssqA + m, lane); }
            }
        }
        GSYNC();
        { pg8::Gemm g{H, W13A, MTOK, 2 * DFF, DM, DM, DM}; pg8::StaticOrder S; S.init(MTOK, 2 * DFF, G, (int)blockIdx.x);
          pg8::EpiSwiGLU E{HID, DFF, ssqA}; pg8::gemm_phase<pg8::EpiSwiGLU, pg8::StaticOrder>(ldsl, g, S, E); }
        GSYNC();
        { pg8::Gemm g{HID, W2A, MTOK, DM, DFF, DFF, DFF}; pg8::StaticOrder S; S.init(MTOK, DM, G, (int)blockIdx.x);
          pg8::EpiResid<true> E{X, H, ssqB, DM, 0.5f, XB8}; pg8::gemm_phase<pg8::EpiResid<true>, pg8::StaticOrder>(ldsl, g, S, E); }
        GSYNC();
        { pg8::Gemm g{H, WIN, MTOK, NIN, DM, DM, DM}; pg8::StaticOrder S; S.init(MTOK, NIN, G, (int)blockIdx.x);
          pg8::EpiBf16<0> E{Z, NIN, nullptr, ssqB, 1.0f}; pg8::gemm_phase<pg8::EpiBf16<0>, pg8::StaticOrder>(ldsl, g, S, E); }
        { pg8::Gemm g{(const bf16_t*)XB8, (const bf16_t*)WG8, MTOK, NG, DM / 2, DM / 2, DM / 2}; pg8::StaticOrder S; S.init(MTOK, NG, G, (int)blockIdx.x);
          pg8::EpiBf16<2> E{GATES, NG, p.in[11] + (size_t)layer * NG, ssqB, 1.0f / WG8_SCALE}; pg8::gemm_phase<pg8::EpiBf16<2>, pg8::StaticOrder, true, true>(ldsl, g, S, E); }
        GSYNC();
        {
            const float* qg = p.in[7] + layer * 128; const float* kg = p.in[8] + layer * 128;
            const int a = lane >> 5, i = lane & 31, e1 = a * 64 + i, e2 = e1 + 32;
            const float invf = exp2f(-(float)(2 * i) * (1.0f / 64.0f) * 13.287712379549449f) * 0.15915494309189535f;
            const float gq1 = qg[e1], gq2 = qg[e2], gk1 = kg[e1], gk2 = kg[e2];
            for (int tok = gw; tok < MTOK; tok += NGW) {
                const int t = tok < 8192 ? (tok & 2047) : ((tok - 8192) & 4095);
                const int pa = a == 0 ? (t >> 6) : (t & 63);
                const float rev = __builtin_amdgcn_fractf((float)pa * invf);
                const float sn = __builtin_amdgcn_sinf(rev), cs = __builtin_amdgcn_cosf(rev);
                bf16_t* zp = Z + (size_t)tok * NIN + 1024;
                float x1[8], x2[8];
#pragma unroll
                for (int hh = 0; hh < 8; ++hh) { x1[hh] = bf2f(zp[hh * 128 + e1]); x2[hh] = bf2f(zp[hh * 128 + e2]); }
#pragma unroll
                for (int hh = 0; hh < 8; ++hh) {
                    const float ss = wave_sum(x1[hh] * x1[hh] + x2[hh] * x2[hh]);
                    const float rs = __builtin_amdgcn_rsqf(ss * (1.0f / 128.0f) + NORM_EPS);
                    const float y1 = x1[hh] * rs * (hh < 6 ? gq1 : gk1), y2 = x2[hh] * rs * (hh < 6 ? gq2 : gk2);
                    const float o1 = y1 * cs - y2 * sn, o2 = y2 * cs + y1 * sn;
                    zp[hh * 128 + e1] = (bf16_t)(cvt_pk_bf16(o1, 0.f) & 0xffffu); zp[hh * 128 + e2] = (bf16_t)(cvt_pk_bf16(o2, 0.f) & 0xffffu);
                }
            }
        }
        GSYNC();
        {
            unsigned* ctr = ctl + layer * 64;
            volatile int* qword = (volatile int*)(lds + att::OFF_Q);
            float* tabs = (float*)(lds + att::OFF_TAB);
            const float* relb = p.in[19];
            const int r32 = lane & 31, hi = lane >> 5;
            for (;;) {
                __syncthreads();
                if (tid == 0) *qword = (int)__hip_atomic_fetch_add(ctr, 1u, __ATOMIC_RELAXED, __HIP_MEMORY_SCOPE_AGENT);
                __syncthreads();
                const int u = *qword;
                if (u >= 1024) break;
                att::AttnP P;
                P.sink = 0.f; P.has_sink = 0; P.omode = 0; P.qpos = 0; P.hw = 0; P.tab = tabs; P.Cp = nullptr; P.cs = 0; P.Lp = nullptr; P.ls = 0; P.Yp = nullptr; P.ys = 0;
                if (u < 384) {
                    int tokbase, L, h, qb;
                    if (u < 192) { const int b = u / 96, rem = u % 96; h = rem / 16; qb = rem % 16; tokbase = 8192 + b * 4096; L = 4096; }
                    else { const int v = u - 192; const int b = v / 48, rem = v % 48; h = rem / 8; qb = rem % 8; tokbase = b * 2048; L = 2048; }
                    const int kvh = h / 3; const int row0 = tokbase + qb * 256 + wave * 32;
                    P.Qw = Z + (size_t)(row0 + r32) * NIN + 1024 + h * 128 + hi * 8;
                    P.Kb = Z + (size_t)tokbase * NIN + 1792 + kvh * 128; P.Vb = Z + (size_t)tokbase * NIN + 2048 + kvh * 128; P.ks = NIN;
                    P.k0 = 0; P.NT = L / 64; P.L = L;
                    P.Yp = Y8 + (size_t)row0 * NY + 512 + h * 128; P.ys = NY;
                    att::attn_body<0>(P, (char*)lds);
                } else {
                    const int g = wave >> 2, wq = wave & 3;
                    if (u < 640) {
                        const int v = u - 384; int tokbase, L, blk, kvh;
                        if (v < 128) { const int b = v / 32, rem = v % 32; blk = rem >> 1; kvh = rem & 1; tokbase = b * 2048; L = 2048; }
                        else { const int v2 = v - 128; const int b = v2 / 64, rem = v2 % 64; blk = rem >> 1; kvh = rem & 1; tokbase = 8192 + b * 4096; L = 4096; }
                        const int head = kvh * 2 + g; const int pos0 = blk * 128 + wq * 32;
                        for (int e = tid; e < 2 * 257; e += 512) { const int gg = e / 257, idx = e - gg * 257; tabs[gg * att::TAB_STRIDE + idx] = relb[t5_bucket(idx - 128) * 10 + kvh * 2 + gg] * att::INV_SCALE; }
                        P.Qw = Z + (size_t)(tokbase + pos0 + r32) * NIN + head * 128 + hi * 8;
                        P.Kb = Z + (size_t)tokbase * NIN + 512 + kvh * 128; P.Vb = Z + (size_t)tokbase * NIN + 768 + kvh * 128; P.ks = NIN;
                        P.k0 = blk * 128 - 128; P.NT = 6; P.L = L; P.qpos = pos0 + r32; P.hw = 128; P.tab = tabs + g * att::TAB_STRIDE;
                        P.sink = p.in[9][layer * 4 + head]; P.has_sink = 1; P.omode = 0;
                        P.Yp = Y8 + (size_t)(tokbase + pos0) * NY + head * 128; P.ys = NY;
                    } else {
                        const int w = u - 640; const int i = w >> 7, v = w & 127; const int r = i == 0 ? 1 : (i == 1 ? 4 : 16);
                        int tokbase, L, ww;
                        if (v < 64) { const int b = v >> 4; ww = v & 15; tokbase = b * 2048; L = 2048; }
                        else { const int b = (v - 64) >> 5; ww = (v - 64) & 31; tokbase = 8192 + b * 4096; L = 4096; }
                        const int Ls = L / r, nblk = Ls >> 7; const int c = ww / nblk, blk = ww - c * nblk;
                        const int qhead = i * 2 + g; const int pos0 = blk * 128 + wq * 32;
                        for (int e = tid; e < 2 * 129; e += 512) { const int gg = e / 129, idx = e - gg * 129; tabs[gg * att::TAB_STRIDE + idx] = relb[t5_bucket((idx - 64) * r) * 10 + 4 + i * 2 + gg] * att::INV_SCALE; }
                        const size_t tok0 = (size_t)tokbase + c;
                        P.Qw = Z + (tok0 + (size_t)(pos0 + r32) * r) * NIN + 2304 + qhead * 128 + hi * 8;
                        P.Kb = Z + tok0 * NIN + 3072 + i * 128; P.Vb = Z + tok0 * NIN + 3456 + i * 128; P.ks = (long)r * NIN;
                        P.k0 = blk * 128 - 64; P.NT = 4; P.L = Ls; P.qpos = pos0 + r32; P.hw = 64; P.tab = tabs + g * att::TAB_STRIDE;
                        P.omode = 1;
                        const size_t orow0 = (size_t)i * MTOK + tok0 + (size_t)pos0 * r;
                        P.Cp = CO + orow0 * 256 + g * 128; P.cs = (long)r * 256; P.Lp = CLSE + orow0 * 2 + g; P.ls = (long)r * 2;
                    }
                    __syncthreads();
                    att::attn_banded(P, (char*)lds);
                }
            }
        }
        GSYNC();
        {
            for (int it0 = gw; it0 < MTOK * 2; it0 += 4 * NGW) {
                f32x2 ca[4], cb[4], cc[4]; float l0[4], l1[4], l2[4];
#pragma unroll
                for (int q = 0; q < 4; ++q) { const int it = it0 + q * NGW, tok = it >> 1, g = it & 1;
                    l0[q] = CLSE[((size_t)0 * MTOK + tok) * 2 + g]; l1[q] = CLSE[((size_t)1 * MTOK + tok) * 2 + g]; l2[q] = CLSE[((size_t)2 * MTOK + tok) * 2 + g];
                    ca[q] = *(const f32x2*)(CO + ((size_t)0 * MTOK + tok) * 256 + g * 128 + lane * 2);
                    cb[q] = *(const f32x2*)(CO + ((size_t)1 * MTOK + tok) * 256 + g * 128 + lane * 2);
                    cc[q] = *(const f32x2*)(CO + ((size_t)2 * MTOK + tok) * 256 + g * 128 + lane * 2); }
#pragma unroll
                for (int q = 0; q < 4; ++q) { const int it = it0 + q * NGW, tok = it >> 1, g = it & 1;
                    const float mx = fmaxf(l0[q], fmaxf(l1[q], l2[q]));
                    float w0 = __expf(l0[q] - mx), w1 = __expf(l1[q] - mx), w2 = __expf(l2[q] - mx); const float inv = 1.0f / (w0 + w1 + w2); w0 *= inv; w1 *= inv; w2 *= inv;
                    *(unsigned short*)(Y8 + (size_t)tok * NY + 1280 + g * 128 + lane * 2) = (unsigned short)(__builtin_amdgcn_cvt_pk_fp8_f32((w0 * ca[q].x + w1 * cb[q].x + w2 * cc[q].x) * Y8_SCALE, (w0 * ca[q].y + w1 * cb[q].y + w2 * cc[q].y) * Y8_SCALE, 0, false) & 0xffff); }
            }
        }
        GSYNC();
        { pg8::Gemm g{(const bf16_t*)Y8, (const bf16_t*)WBR8, MTOK, DM, NY / 2, NY / 2, NY / 2}; pg8::MergeOrder S; S.init(MTOK, DM, G, (int)blockIdx.x);
          pg8::EpiMerge E{GATES, NG, MRG, DM, 1.0f / (Y8_SCALE * Y8_SCALE)}; pg8::gemm_phase<pg8::EpiMerge, pg8::MergeOrder, true, true>(ldsl, g, S, E); }
        GSYNC();
        { pg8::Gemm g{MRG, WO, MTOK, DM, DM, DM, DM}; pg8::StaticOrder S; S.init(MTOK, DM, G, (int)blockIdx.x);
          pg8::EpiResid<false> E{X, H, ssqC, DM, 1.0f, nullptr}; pg8::gemm_phase<pg8::EpiResid<false>, pg8::StaticOrder>(ldsl, g, S, E); }
        GSYNC();
        { pg8::Gemm g{H, W13B, MTOK, 2 * DFF, DM, DM, DM}; pg8::StaticOrder S; S.init(MTOK, 2 * DFF, G, (int)blockIdx.x);
          pg8::EpiSwiGLU E{HID, DFF, ssqC}; pg8::gemm_phase<pg8::EpiSwiGLU, pg8::StaticOrder>(ldsl, g, S, E); }
        GSYNC();
        { pg8::Gemm g{HID, W2B, MTOK, DM, DFF, DFF, DFF}; pg8::StaticOrder S; S.init(MTOK, DM, G, (int)blockIdx.x);
          pg8::EpiResid<false, layer + 1 < DEPTH> E{X, H, ssqN, DM, 0.5f, nullptr}; pg8::gemm_phase<pg8::EpiResid<false, layer + 1 < DEPTH>, pg8::StaticOrder>(ldsl, g, S, E); }
        GSYNC();
    }
}

__global__ void __launch_bounds__(512, 2) fwd_megakernel(Params p) {
    extern __shared__ __attribute__((aligned(16))) unsigned char lds[];
    constexpr size_t WS_BAR = 768 * 1024;
    if (blockIdx.x == 0) {
        if (threadIdx.x < 64) __hip_atomic_store((unsigned*)(p.ws + WS_CTL) + threadIdx.x * 64, 0u, __ATOMIC_RELAXED, __HIP_MEMORY_SCOPE_AGENT);
        for (int i = threadIdx.x; i < XCD_BAR_WORDS; i += 512) __hip_atomic_store((unsigned*)(p.ws + WS_BAR) + i, 0u, __ATOMIC_RELAXED, __HIP_MEMORY_SCOPE_AGENT);
    }
    { float* sq = (float*)(p.ws + 65536) + MTOK;
      for (int i = blockIdx.x * 512 + threadIdx.x; i < 6 * MTOK; i += gridDim.x * 512) sq[i] = 0.f; }
    volatile LAS unsigned* bst = (volatile LAS unsigned*)((LAS unsigned char*)lds + RING_BYTES + 1024);
    if (threadIdx.x < 2) bst[threadIdx.x] = 0u;
    asm volatile("s_waitcnt vmcnt(0) lgkmcnt(0)" ::: "memory");
    cg::this_grid().sync();
    const XcdBarrier xbar = xcd_barrier_post((unsigned*)(p.ws + WS_BAR), bst);
    run_layer<0>(p, lds, xbar);
    run_layer<1>(p, lds, xbar);
    const int lane = threadIdx.x & 63, gw = blockIdx.x * 8 + (threadIdx.x >> 6), NGW = gridDim.x * 8;
    for (int m = gw; m < MTOK; m += NGW) rms_row_f32(p.out + (size_t)m * DM, p.in[20], lane);
}

extern "C" void kernel_launch(void* const* d_in, const int* in_sizes, int n_in, void* d_out, int out_size, void* d_ws, size_t ws_size, hipStream_t stream) {
    static int grid = 0;
    if (grid == 0) {
        if (n_in != 21 || out_size != MTOK * DM || ws_size < WS_END) { fprintf(stderr, "kernel_launch: unexpected shapes (n_in %d out %d ws %zu)\n", n_in, out_size, ws_size); grid = -1; return; }
        int dev = 0, cus = 0, per_cu = 0;
        hipGetDevice(&dev); hipDeviceGetAttribute(&cus, hipDeviceAttributeMultiprocessorCount, dev);
        if (hipFuncSetAttribute((const void*)fwd_megakernel, hipFuncAttributeMaxDynamicSharedMemorySize, LDS_BYTES) != hipSuccess) { fprintf(stderr, "kernel_launch: hipFuncSetAttribute failed\n"); grid = -1; return; }
        if (hipOccupancyMaxActiveBlocksPerMultiprocessor(&per_cu, (const void*)fwd_megakernel, 512, LDS_BYTES) != hipSuccess || per_cu < 1) { fprintf(stderr, "kernel_launch: occupancy query failed (%d)\n", per_cu); per_cu = 1; }
        (void)hipGetLastError();
        grid = cus * 1;
    }
    if (grid < 0) return;
    Params p{};
    for (int i = 0; i < 21; ++i) p.in[i] = (const float*)d_in[i];
    p.out = (float*)d_out; p.ws = (unsigned char*)d_ws;
    void* args[] = {&p};
    hipError_t e = hipLaunchCooperativeKernel((const void*)fwd_megakernel, dim3(grid), dim3(512), args, LDS_BYTES, stream);
    if (e != hipSuccess) fprintf(stderr, "cooperative launch failed: %s (grid %d)\n", hipGetErrorString(e), grid);
}
```
